# Optimizing an MI355X kernel written in HIP

```python
import jax
import jax.numpy as jnp
from jax import lax
import numpy as np

D_MODEL = 1024
BATCH = 16
SEQ = 2048
DEPTH = 1

FOX_HEADS = 8
FOX_HEAD_DIM = 64
FOX_WIDTH = FOX_HEADS * FOX_HEAD_DIM
Q_BLOCK = 128
FORGET_BIAS_INIT = 5.0
GMLP_GROUPS = 8
GMLP_GROUP_DIM = 64
GMLP_WIDTH = GMLP_GROUPS * GMLP_GROUP_DIM
GMLP_CHUNK = 128
N_EXPERTS = 32
TOP_K = 4
D_FF = D_MODEL
SWIGLU_LIMIT = 7.0
SWIGLU_ALPHA = 1.702
MOE_BLOCK = 128
PLE_DIM = 256
LN_EPS = 1e-5
DEEPNORM_ALPHA = (2.0 * DEPTH) ** 0.25
DEEPNORM_BETA = (8.0 * DEPTH) ** -0.25

OFF_Q = 0
OFF_K = OFF_Q + FOX_WIDTH
OFF_V = OFF_K + FOX_WIDTH
OFF_F = OFF_V + FOX_WIDTH
OFF_U = OFF_F + FOX_HEADS
OFF_GV = OFF_U + GMLP_WIDTH
OFF_GA = OFF_GV + GMLP_WIDTH
OFF_GB = OFF_GA + D_MODEL
D_IN_PROJ = OFF_GB + D_MODEL
SPLIT_POINTS = (OFF_K, OFF_V, OFF_F, OFF_U, OFF_GV, OFF_GA, OFF_GB)

kernel_name = 'hybrid_fox_gmlp_moe_block'


def layer_norm(x, g, b):
    xf = x.astype(jnp.float32)
    mu = jnp.mean(xf, axis=-1, keepdims=True)
    var = jnp.mean(jnp.square(xf - mu), axis=-1, keepdims=True)
    return ((xf - mu) * lax.rsqrt(var + LN_EPS) * g + b).astype(x.dtype)


def forgetting_attention(q, k, v, f_logit):
    B, S, H, Dh = q.shape
    c = jnp.cumsum(jax.nn.log_sigmoid(f_logit.astype(jnp.float32)), axis=1)
    c = jnp.transpose(c, (0, 2, 1))
    q = jnp.transpose(q, (0, 2, 1, 3))
    k = jnp.transpose(k, (0, 2, 1, 3))
    v = jnp.transpose(v, (0, 2, 1, 3))
    scale = Dh ** -0.5
    outs = []
    for blk in range(S // Q_BLOCK):
        q0 = blk * Q_BLOCK
        kv_len = q0 + Q_BLOCK
        qb = q[:, :, q0:kv_len]
        kb = k[:, :, :kv_len]
        vb = v[:, :, :kv_len]
        logits = jnp.einsum('bhtd,bhsd->bhts', qb, kb).astype(jnp.float32) * scale
        logits = logits + c[:, :, q0:kv_len, None] - c[:, :, None, :kv_len]
        causal = jnp.arange(kv_len)[None, :] <= (q0 + jnp.arange(Q_BLOCK))[:, None]
        logits = jnp.where(causal, logits, -jnp.inf)
        probs = jax.nn.softmax(logits, axis=-1).astype(v.dtype)
        outs.append(jnp.einsum('bhts,bhsd->bthd', probs, vb))
    return jnp.concatenate(outs, axis=1).reshape(B, S, H * Dh)


def spatial_gating(u, v, ln_g, ln_b, w_s, b_s):
    B, S, _ = u.shape
    u = jax.nn.gelu(u)
    v = layer_norm(jax.nn.gelu(v), ln_g, ln_b)
    v = v.reshape(B, S // GMLP_CHUNK, GMLP_CHUNK, GMLP_GROUPS, GMLP_GROUP_DIM)
    w = w_s * jnp.tril(jnp.ones((GMLP_CHUNK, GMLP_CHUNK), w_s.dtype))
    s = jnp.einsum('gts,bnsgd->bntgd', w, v) + b_s.T[None, None, :, :, None]
    return u * s.reshape(B, S, GMLP_WIDTH)


def expert_ffn(xb, w_gu, b_gu, w_dn, b_dn):
    gu = xb @ w_gu + b_gu
    gate = jnp.minimum(gu[..., :D_FF], SWIGLU_LIMIT)
    up = jnp.clip(gu[..., D_FF:], -SWIGLU_LIMIT, SWIGLU_LIMIT)
    h = (up + 1.0) * (gate * jax.nn.sigmoid(SWIGLU_ALPHA * gate))
    return h @ w_dn + b_dn


def moe_ffn(x, w_router, b_router, w_gu, b_gu, w_dn, b_dn):
    B, S, D = x.shape
    T = B * S
    n_assign = T * TOP_K
    xf = x.reshape(T, D)
    logits = xf.astype(jnp.float32) @ w_router.astype(jnp.float32) + b_router.astype(jnp.float32)
    top_val, top_idx = lax.top_k(logits, TOP_K)
    gates = jax.nn.softmax(top_val, axis=-1).astype(x.dtype)
    e_flat = top_idx.reshape(-1).astype(jnp.int32)
    tok_flat = jnp.arange(n_assign, dtype=jnp.int32) // TOP_K
    order = jnp.argsort(e_flat)
    e_sorted = e_flat[order]
    tok_sorted = tok_flat[order]
    g_sorted = gates.reshape(-1)[order]
    counts = jnp.bincount(e_flat, length=N_EXPERTS).astype(jnp.int32)
    starts = jnp.cumsum(counts) - counts
    padded = (counts + MOE_BLOCK - 1) // MOE_BLOCK * MOE_BLOCK
    pad_end = jnp.cumsum(padded)
    pad_start = pad_end - padded
    rank = jnp.arange(n_assign, dtype=jnp.int32) - starts[e_sorted]
    dest = pad_start[e_sorted] + rank
    n_blocks = -(-n_assign // MOE_BLOCK) + N_EXPERTS
    x_pad = jnp.zeros((n_blocks * MOE_BLOCK, D), x.dtype).at[dest].set(xf[tok_sorted])
    block_start = jnp.arange(n_blocks, dtype=jnp.int32) * MOE_BLOCK
    block_expert = jnp.minimum(jnp.searchsorted(pad_end, block_start, side='right'), N_EXPERTS - 1)

    def run_block(args):
        xb, e = args
        return expert_ffn(xb, w_gu[e], b_gu[e], w_dn[e], b_dn[e])

    y_pad = lax.map(run_block, (x_pad.reshape(n_blocks, MOE_BLOCK, D), block_expert))
    y_sorted = y_pad.reshape(-1, D)[dest] * g_sorted[:, None]
    return jax.ops.segment_sum(y_sorted, tok_sorted, num_segments=T).reshape(B, S, D)


def setup_inputs(seed: int = 0) -> dict:
    key = jax.random.key(seed)
    ks = jax.random.split(key, 32)
    f32 = jnp.float32
    L = DEPTH

    def nrm(k, shape, scale):
        return scale * jax.random.normal(k, shape, f32)

    col_scale = jnp.ones((D_IN_PROJ,), f32).at[OFF_V:OFF_F].set(DEEPNORM_BETA)
    return {
        'x': nrm(ks[0], (BATCH, SEQ, D_MODEL), 1.0),
        'p': nrm(ks[1], (DEPTH, BATCH, SEQ, PLE_DIM), 1.0),
        'w_in': nrm(ks[2], (L, D_MODEL, D_IN_PROJ), D_MODEL ** -0.5) * col_scale,
        'b_in': nrm(ks[3], (L, D_IN_PROJ), 0.02).at[:, OFF_F:OFF_U].add(FORGET_BIAS_INIT),
        'gmlp_ln_g': 1.0 + nrm(ks[4], (L, GMLP_WIDTH), 0.02),
        'gmlp_ln_b': nrm(ks[5], (L, GMLP_WIDTH), 0.02),
        'w_spatial': nrm(ks[6], (L, GMLP_GROUPS, GMLP_CHUNK, GMLP_CHUNK), GMLP_CHUNK ** -0.5),
        'b_spatial': 1.0 + nrm(ks[7], (L, GMLP_GROUPS, GMLP_CHUNK), 0.02),
        'w_branch_a': nrm(ks[8], (L, FOX_WIDTH, D_MODEL), FOX_WIDTH ** -0.5 * DEEPNORM_BETA),
        'w_branch_b': nrm(ks[9], (L, GMLP_WIDTH, D_MODEL), GMLP_WIDTH ** -0.5 * DEEPNORM_BETA),
        'w_out': nrm(ks[10], (L, D_MODEL, D_MODEL), D_MODEL ** -0.5 * DEEPNORM_BETA),
        'b_out': nrm(ks[11], (L, D_MODEL), 0.02),
        'ln1_g': 1.0 + nrm(ks[12], (L, D_MODEL), 0.02),
        'ln1_b': nrm(ks[13], (L, D_MODEL), 0.02),
        'w_router': nrm(ks[14], (L, D_MODEL, N_EXPERTS), D_MODEL ** -0.5),
        'b_router': nrm(ks[15], (L, N_EXPERTS), 0.01),
        'w_gate_up': nrm(ks[16], (L, N_EXPERTS, D_MODEL, 2 * D_FF), D_MODEL ** -0.5),
        'b_gate_up': nrm(ks[17], (L, N_EXPERTS, 2 * D_FF), 0.02),
        'w_down': nrm(ks[18], (L, N_EXPERTS, D_FF, D_MODEL), D_FF ** -0.5 * DEEPNORM_BETA),
        'b_down': nrm(ks[19], (L, N_EXPERTS, D_MODEL), 0.02),
        'ln2_g': 1.0 + nrm(ks[20], (L, D_MODEL), 0.02),
        'ln2_b': nrm(ks[21], (L, D_MODEL), 0.02),
        'w_ple': nrm(ks[22], (L, PLE_DIM, D_MODEL), PLE_DIM ** -0.5 * DEEPNORM_BETA),
        'w_ple_gate': nrm(ks[23], (L, D_MODEL, D_MODEL), D_MODEL ** -0.5),
        'b_ple_gate': nrm(ks[24], (L, D_MODEL), 0.02),
        'ln3_g': 1.0 + nrm(ks[25], (L, D_MODEL), 0.02),
        'ln3_b': nrm(ks[26], (L, D_MODEL), 0.02),
    }


def reference(x, p, w_in, b_in, gmlp_ln_g, gmlp_ln_b, w_spatial, b_spatial,
              w_branch_a, w_branch_b, w_out, b_out, ln1_g, ln1_b,
              w_router, b_router, w_gate_up, b_gate_up, w_down, b_down,
              ln2_g, ln2_b, w_ple, w_ple_gate, b_ple_gate, ln3_g, ln3_b):
    h = x
    B, S, _ = h.shape
    for i in range(DEPTH):
        proj = h @ w_in[i] + b_in[i]
        q, k, v, f_logit, u, gv, gate_a, gate_b = jnp.split(proj, SPLIT_POINTS, axis=-1)
        attn = forgetting_attention(q.reshape(B, S, FOX_HEADS, FOX_HEAD_DIM),
                                    k.reshape(B, S, FOX_HEADS, FOX_HEAD_DIM),
                                    v.reshape(B, S, FOX_HEADS, FOX_HEAD_DIM),
                                    f_logit)
        sgu = spatial_gating(u, gv, gmlp_ln_g[i], gmlp_ln_b[i], w_spatial[i], b_spatial[i])
        merged = (jax.nn.sigmoid(gate_a) * (attn @ w_branch_a[i])
                  + jax.nn.sigmoid(gate_b) * (sgu @ w_branch_b[i]))
        mix = merged @ w_out[i] + b_out[i]
        h = layer_norm(DEEPNORM_ALPHA * h + mix, ln1_g[i], ln1_b[i])
        ffn = moe_ffn(h, w_router[i], b_router[i], w_gate_up[i], b_gate_up[i], w_down[i], b_down[i])
        h = layer_norm(DEEPNORM_ALPHA * h + ffn, ln2_g[i], ln2_b[i])
        ple = (p[i] @ w_ple[i]) * jax.nn.sigmoid(h @ w_ple_gate[i] + b_ple_gate[i])
        h = layer_norm(DEEPNORM_ALPHA * h + ple, ln3_g[i], ln3_b[i])
    return h
```

```cpp
#include <hip/hip_runtime.h>
#include <cstdio>
#include <cstdint>

typedef unsigned short bf16;
typedef short bf16x8 __attribute__((ext_vector_type(8)));
typedef float f32x4 __attribute__((ext_vector_type(4)));
typedef float f32x16 __attribute__((ext_vector_type(16)));
typedef unsigned u32x2 __attribute__((ext_vector_type(2)));
typedef unsigned u32x4 __attribute__((ext_vector_type(4)));

constexpr int NB = 16, SEQ = 2048, T = NB * SEQ, DM = 1024, NH = 8, HD = 64, FW = 512, GW = 512, CHUNK = 128, NGRP = 8;
constexpr int NE = 32, TOPK = 4, DFF = 1024, PLE = 256;
constexpr int OFF_F = 1536, DIN = 4616, DINC = 4608;
constexpr float LN_EPS = 1e-5f, ALPHA = 1.189207115002721f, LOG2E = 1.4426950408889634f;
constexpr float QSCALE = 0.125f * LOG2E;
constexpr int ROWCAP = 139264;
constexpr int NTILE256 = ROWCAP / 256;

constexpr size_t MiB = 1u << 20;
constexpr size_t WS_CTL = 0, CTL_BYTES = 1 * MiB;
constexpr size_t WS_WIN = 1 * MiB, WS_WA = 10 * MiB, WS_WB = 11 * MiB, WS_WO = 12 * MiB, WS_WPG = 14 * MiB, WS_WPLE = 16 * MiB, WS_WSP = 17 * MiB;
constexpr size_t WS_FLOG = 18 * MiB, WS_CN = 19 * MiB, WS_TOPG = 20 * MiB, WS_POS = 20 * MiB + 512 * 1024, WS_LIST = 21 * MiB, WS_ROWTOK = 25 * MiB, WS_ROWG = 26 * MiB, WS_TILEE = 27 * MiB;
constexpr size_t WS_PB = 28 * MiB, WS_WGU = 44 * MiB, WS_WDN = 172 * MiB, WS_HB = 236 * MiB, WS_A = 300 * MiB, WS_END = 844 * MiB;
constexpr size_t A_XB = 0, A_Q = 64 * MiB, A_K = 96 * MiB, A_V = 128 * MiB, A_GU = 160 * MiB, A_GV = 192 * MiB, A_GA = 224 * MiB, A_GB = 288 * MiB, A_ATT = 352 * MiB, A_SGU = 384 * MiB, A_MRG = 416 * MiB;
constexpr size_t A_TMPF = 0;
constexpr size_t A_HID = 0, A_Y = 272 * MiB;
constexpr size_t A_G = 0;
constexpr int CW_CNT = 64;

__device__ __forceinline__ bf16 f2bf(float f) { unsigned u = __builtin_bit_cast(unsigned, f); return (bf16)((u + 0x7fffu + ((u >> 16) & 1u)) >> 16); }
__device__ __forceinline__ float bf2f(bf16 h) { return __builtin_bit_cast(float, (unsigned)h << 16); }
__device__ __forceinline__ unsigned pk2(float lo, float hi) { return (unsigned)f2bf(lo) | ((unsigned)f2bf(hi) << 16); }
__device__ __forceinline__ float sigmoidf_(float v) { return 1.f / (1.f + __expf(-v)); }
__device__ __forceinline__ float gelu_tanh(float v) { const float u = 0.7978845608028654f * (v + 0.044715f * v * v * v); return v / (1.f + __expf(-2.f * u)); }
__device__ __forceinline__ float wave_sum(float v) {
#pragma unroll
    for (int o = 1; o < 64; o <<= 1) v += __shfl_xor(v, o);
    return v;
}
__device__ __forceinline__ float wave_max(float v) {
#pragma unroll
    for (int o = 1; o < 64; o <<= 1) v = fmaxf(v, __shfl_xor(v, o));
    return v;
}

template <int MODE> __device__ __forceinline__ int colmap(int n) {
    if (MODE == 1) return n < OFF_F ? n : n + 8;
    if (MODE == 2) { const int tile = n >> 8, half = (n >> 7) & 1, c = n & 127; return half * DFF + tile * 128 + c; }
    return n;
}
template <int MODE> __global__ void __launch_bounds__(256) k_convT(const float* W, bf16* Wt, int K, int Nsrc, size_t src_stride, size_t dst_stride) {
    __shared__ float tile[32][33];
    W += blockIdx.z * src_stride; Wt += blockIdx.z * dst_stride;
    const int n0 = blockIdx.x * 32, k0 = blockIdx.y * 32, tx = threadIdx.x & 31, ty = threadIdx.x >> 5;
    for (int i = ty; i < 32; i += 8) tile[i][tx] = W[(size_t)(k0 + i) * Nsrc + colmap<MODE>(n0 + tx)];
    __syncthreads();
    for (int i = ty; i < 32; i += 8) Wt[(size_t)(n0 + i) * K + k0 + tx] = f2bf(tile[tx][i]);
}
__global__ void __launch_bounds__(256) k_conv_wsp(const float* w, bf16* o) {
    const int i = blockIdx.x * 256 + threadIdx.x; const int s = i & 127, t = (i >> 7) & 127;
    o[i] = s <= t ? f2bf(w[i]) : (bf16)0;
}
__global__ void __launch_bounds__(256) k_conv_p(const float* p, bf16* o) {
    const size_t i = ((size_t)blockIdx.x * 256 + threadIdx.x) * 4; const f32x4 v = *(const f32x4*)(p + i);
    u32x2 w; w.x = pk2(v[0], v[1]); w.y = pk2(v[2], v[3]); *(u32x2*)(o + i) = w;
}
__global__ void __launch_bounds__(256) k_prep_x(const float* x, const float* w_in, const float* b_in, bf16* XB, float* FLOG) {
    const int t = (blockIdx.x * 256 + threadIdx.x) >> 6, lane = threadIdx.x & 63;
    const float* xr = x + (size_t)t * DM;
    float f0 = 0, f1 = 0, f2 = 0, f3 = 0, f4 = 0, f5 = 0, f6 = 0, f7 = 0;
#pragma unroll
    for (int j = 0; j < 4; ++j) {
        const int k0 = 4 * lane + 256 * j; const f32x4 v = *(const f32x4*)(xr + k0);
        u32x2 w; w.x = pk2(v[0], v[1]); w.y = pk2(v[2], v[3]); *(u32x2*)(XB + (size_t)t * DM + k0) = w;
#pragma unroll
        for (int c = 0; c < 4; ++c) { const float* wr = w_in + (size_t)(k0 + c) * DIN + OFF_F; const f32x4 w0 = *(const f32x4*)wr, w1 = *(const f32x4*)(wr + 4); const float xv = v[c];
            f0 += xv * w0[0]; f1 += xv * w0[1]; f2 += xv * w0[2]; f3 += xv * w0[3]; f4 += xv * w1[0]; f5 += xv * w1[1]; f6 += xv * w1[2]; f7 += xv * w1[3]; }
    }
    f0 = wave_sum(f0); f1 = wave_sum(f1); f2 = wave_sum(f2); f3 = wave_sum(f3); f4 = wave_sum(f4); f5 = wave_sum(f5); f6 = wave_sum(f6); f7 = wave_sum(f7);
    if (lane == 0) { float* o = FLOG + (size_t)t * 8; const float* bb = b_in + OFF_F;
        o[0] = f0 + bb[0]; o[1] = f1 + bb[1]; o[2] = f2 + bb[2]; o[3] = f3 + bb[3]; o[4] = f4 + bb[4]; o[5] = f5 + bb[5]; o[6] = f6 + bb[6]; o[7] = f7 + bb[7]; }
}
__global__ void __launch_bounds__(256) k_cumsum(const float* FLOG, float* CN) {
    __shared__ float part[256];
    const int bh = blockIdx.x, b = bh >> 3, h = bh & 7, tid = threadIdx.x;
    float v[8]; float s = 0.f;
#pragma unroll
    for (int i = 0; i < 8; ++i) { const float f = FLOG[((size_t)b * SEQ + tid * 8 + i) * 8 + h]; s += fminf(f, 0.f) - log1pf(expf(-fabsf(f))); v[i] = s; }
    part[tid] = s; __syncthreads();
    for (int off = 1; off < 256; off <<= 1) { const float tt = tid >= off ? part[tid - off] : 0.f; __syncthreads(); part[tid] += tt; __syncthreads(); }
    const float base = tid ? part[tid - 1] : 0.f;
#pragma unroll
    for (int i = 0; i < 8; ++i) CN[(size_t)bh * SEQ + tid * 8 + i] = (base + v[i]) * LOG2E;
}
__global__ void __launch_bounds__(256) k_attn_naive(const bf16* Q, const bf16* K, const bf16* V, const float* CN, bf16* ATT) {
    const int gw = (blockIdx.x * 256 + threadIdx.x) >> 6, lane = threadIdx.x & 63;
    const int t = gw & (SEQ - 1), h = (gw >> 11) & 7, b = gw >> 14;
    const size_t row = (size_t)b * SEQ + t;
    float q[64];
#pragma unroll
    for (int d = 0; d < 64; d += 8) { const bf16x8 r = *(const bf16x8*)(Q + row * FW + h * HD + d);
#pragma unroll
        for (int i = 0; i < 8; ++i) q[d + i] = bf2f((bf16)r[i]); }
    const float* cn = CN + (size_t)(b * NH + h) * SEQ; const float ct = cn[t];
    float m = -INFINITY, l = 0.f, acc = 0.f;
    for (int s0 = 0; s0 <= t; s0 += 64) {
        const int s = s0 + lane; float logit = -INFINITY;
        if (s <= t) { const bf16* kr = K + ((size_t)b * SEQ + s) * FW + h * HD; float dot = 0.f;
#pragma unroll
            for (int d = 0; d < 64; d += 8) { const bf16x8 r = *(const bf16x8*)(kr + d);
#pragma unroll
                for (int i = 0; i < 8; ++i) dot += q[d + i] * bf2f((bf16)r[i]); }
            logit = dot + (ct - cn[s]); }
        const float mn = fmaxf(m, wave_max(logit));
        const float p = (s <= t) ? exp2f(logit - mn) : 0.f;
        const float sc = exp2f(m - mn);
        l = l * sc + wave_sum(p); acc *= sc;
        const int n = (t - s0 + 1) < 64 ? (t - s0 + 1) : 64;
        for (int j = 0; j < n; ++j) { const float pj = __shfl(p, j); acc += pj * bf2f(V[((size_t)b * SEQ + s0 + j) * FW + h * HD + lane]); }
        m = mn;
    }
    ATT[row * FW + h * HD + lane] = f2bf(acc / l);
}
__global__ void __launch_bounds__(256) k_sgu_naive(const bf16* GV, const bf16* GU, const float* ln_g, const float* ln_b, const bf16* WSP, const float* b_sp, bf16* SGU) {
    __shared__ float vln[128][65];
    const int g = blockIdx.x & 7, n = (blockIdx.x >> 3) & 15, b = blockIdx.x >> 7, tid = threadIdx.x, wave = tid >> 6, lane = tid & 63;
    const size_t row0 = (size_t)b * SEQ + n * CHUNK;
    for (int r = wave; r < 128; r += 4) {
        const bf16x8 raw = *(const bf16x8*)(GV + (row0 + r) * GW + lane * 8); float x[8]; float s = 0.f;
#pragma unroll
        for (int i = 0; i < 8; ++i) { x[i] = bf2f((bf16)raw[i]); s += x[i]; }
        const float mean = wave_sum(s) * (1.f / GW); float s2 = 0.f;
#pragma unroll
        for (int i = 0; i < 8; ++i) { x[i] -= mean; s2 += x[i] * x[i]; }
        const float rstd = 1.f / sqrtf(wave_sum(s2) * (1.f / GW) + LN_EPS);
        if ((lane >> 3) == g) {
#pragma unroll
            for (int i = 0; i < 8; ++i) { const int c = lane * 8 + i; vln[r][c - g * 64] = x[i] * rstd * ln_g[c] + ln_b[c]; } }
    }
    __syncthreads();
    const int t = tid >> 1, dh = (tid & 1) * 32;
    float acc[32];
#pragma unroll
    for (int d = 0; d < 32; ++d) acc[d] = 0.f;
    for (int s = 0; s <= t; ++s) { const float w = bf2f(WSP[(size_t)(g * 128 + t) * 128 + s]);
#pragma unroll
        for (int d = 0; d < 32; ++d) acc[d] += w * vln[s][dh + d]; }
    const float bs = b_sp[g * 128 + t];
#pragma unroll
    for (int d = 0; d < 32; ++d) { const size_t idx = (row0 + t) * GW + g * 64 + dh + d; SGU[idx] = f2bf(bf2f(GU[idx]) * (acc[d] + bs)); }
}
template <int MODE> __global__ void __launch_bounds__(256) k_ln_rows(float* X, const float* g, const float* bta, bf16* XBo, const bf16* Y, const int* POS) {
    const int row = (blockIdx.x * 256 + threadIdx.x) >> 6, lane = threadIdx.x & 63;
    float* xr = X + (size_t)row * DM; f32x4 v[4]; float s = 0.f;
#pragma unroll
    for (int j = 0; j < 4; ++j) v[j] = *(const f32x4*)(xr + 4 * lane + 256 * j);
    if (MODE == 1) {
#pragma unroll
        for (int j = 0; j < 4; ++j) v[j] = v[j] * ALPHA;
#pragma unroll
        for (int k = 0; k < TOPK; ++k) { const bf16* yr = Y + (size_t)POS[row * TOPK + k] * DM;
#pragma unroll
            for (int j = 0; j < 4; ++j) { const u32x2 w = *(const u32x2*)(yr + 4 * lane + 256 * j);
                v[j][0] += bf2f((bf16)(w.x & 0xffff)); v[j][1] += bf2f((bf16)(w.x >> 16)); v[j][2] += bf2f((bf16)(w.y & 0xffff)); v[j][3] += bf2f((bf16)(w.y >> 16)); } }
    }
#pragma unroll
    for (int j = 0; j < 4; ++j) s += (v[j][0] + v[j][1]) + (v[j][2] + v[j][3]);
    const float mean = wave_sum(s) * (1.f / DM); float s2 = 0.f;
#pragma unroll
    for (int j = 0; j < 4; ++j) { v[j] = v[j] - mean; s2 += (v[j][0] * v[j][0] + v[j][1] * v[j][1]) + (v[j][2] * v[j][2] + v[j][3] * v[j][3]); }
    const float rstd = 1.f / sqrtf(wave_sum(s2) * (1.f / DM) + LN_EPS);
#pragma unroll
    for (int j = 0; j < 4; ++j) { const int c = 4 * lane + 256 * j; const f32x4 gg = *(const f32x4*)(g + c), bb = *(const f32x4*)(bta + c);
        const f32x4 o = v[j] * rstd * gg + bb; *(f32x4*)(xr + c) = o;
        if (XBo) { u32x2 w; w.x = pk2(o[0], o[1]); w.y = pk2(o[2], o[3]); *(u32x2*)(XBo + (size_t)row * DM + c) = w; } }
}
__global__ void __launch_bounds__(256) k_router_naive(const float* H1, const float* w_router, const float* b_router, float* TOPG, unsigned* cnt, int* LIST) {
    const int t = (blockIdx.x * 256 + threadIdx.x) >> 6, lane = threadIdx.x & 63, e = lane & 31, half = lane >> 5;
    const float* hr = H1 + (size_t)t * DM + half * 512; const float* wr = w_router + (size_t)(half * 512) * NE + e;
    float acc = 0.f;
#pragma unroll 8
    for (int k = 0; k < 512; ++k) acc += hr[k] * wr[(size_t)k * NE];
    acc += __shfl_xor(acc, 32);
    float cur = acc + b_router[e];
    float v0, v1, v2, v3; int i0, i1, i2, i3;
    { float mx = wave_max(cur); int win = __ffsll((unsigned long long)__ballot(cur == mx)) - 1; v0 = mx; i0 = win; if (e == win) cur = -INFINITY; }
    { float mx = wave_max(cur); int win = __ffsll((unsigned long long)__ballot(cur == mx)) - 1; v1 = mx; i1 = win; if (e == win) cur = -INFINITY; }
    { float mx = wave_max(cur); int win = __ffsll((unsigned long long)__ballot(cur == mx)) - 1; v2 = mx; i2 = win; if (e == win) cur = -INFINITY; }
    { float mx = wave_max(cur); int win = __ffsll((unsigned long long)__ballot(cur == mx)) - 1; v3 = mx; i3 = win; }
    const float e0 = 1.f, e1 = __expf(v1 - v0), e2 = __expf(v2 - v0), e3 = __expf(v3 - v0), inv = 1.f / (e0 + e1 + e2 + e3);
    if (lane < 4) { const int ei = lane == 0 ? i0 : lane == 1 ? i1 : lane == 2 ? i2 : i3; const float gi = (lane == 0 ? e0 : lane == 1 ? e1 : lane == 2 ? e2 : e3) * inv;
        const unsigned pos = atomicAdd(cnt + ei, 1u); LIST[(size_t)ei * T + pos] = t * TOPK + lane; TOPG[t * TOPK + lane] = gi; }
}
__global__ void __launch_bounds__(256) k_scatter_naive(const unsigned* cnt, const int* LIST, const float* TOPG, int* ROWTOK, float* ROWG, int* POS, int* TILEE) {
    const int row = blockIdx.x * 256 + threadIdx.x; int base = 0, e = -1, pos = 0, ce = 0;
    for (int j = 0; j < NE; ++j) { const int c = (int)cnt[j], pc = (c + 255) & ~255; if (e < 0 && row < base + pc) { e = j; pos = row - base; ce = c; } base += pc; }
    if (threadIdx.x == 0) TILEE[blockIdx.x] = e;
    if (e >= 0 && pos < ce) { const int tk = LIST[(size_t)e * T + pos]; ROWTOK[row] = tk >> 2; ROWG[row] = TOPG[tk]; POS[tk] = row; }
    else { ROWTOK[row] = 0; ROWG[row] = 0.f; }
}
struct NG { const bf16* A; const int* rowidx; const bf16* Bt; const int* tile_e; size_t b_stride; int lda, ldb, K, pad; };
static NG mkng(const bf16* A, int lda, const int* rowidx, const bf16* Bt, int ldb, int K, const int* tile_e, size_t b_stride) { NG g; g.A = A; g.rowidx = rowidx; g.Bt = Bt; g.tile_e = tile_e; g.b_stride = b_stride; g.lda = lda; g.ldb = ldb; g.K = K; g.pad = 0; return g; }
template <class Epi, bool DUAL> __global__ void __launch_bounds__(256) k_ngemm(NG g, Epi ep) {
    const int w = threadIdx.x >> 6, lane = threadIdx.x & 63, r = lane & 31, h = lane >> 5;
    const int tm = blockIdx.y * 128 + (w >> 1) * 64, tn = blockIdx.x * 128 + (w & 1) * 64;
    int e = 0; if (g.tile_e) { e = g.tile_e[tm >> 8]; if (e < 0) return; }
    const bf16* Bt = g.Bt + (size_t)e * g.b_stride;
    const bf16* ap[2]; const bf16* bp[2]; const bf16* bp2[2];
#pragma unroll
    for (int i = 0; i < 2; ++i) { const int rr = tm + i * 32 + r; const int ar = g.rowidx ? g.rowidx[rr] : rr; ap[i] = g.A + (size_t)ar * g.lda + 8 * h; }
#pragma unroll
    for (int j = 0; j < 2; ++j) { const int nn = tn + j * 32 + r; const int br = DUAL ? ((nn >> 7) * 256 + (nn & 127)) : nn; bp[j] = Bt + (size_t)br * g.ldb + 8 * h; bp2[j] = bp[j] + (size_t)128 * g.ldb; }
    f32x16 acc[2][2], acc2[2][2];
#pragma unroll
    for (int i = 0; i < 2; ++i)
#pragma unroll
        for (int j = 0; j < 2; ++j) { acc[i][j] = f32x16{}; acc2[i][j] = f32x16{}; }
#pragma unroll 2
    for (int k0 = 0; k0 < g.K; k0 += 16) {
        bf16x8 a[2], b[2], b2[2];
#pragma unroll
        for (int i = 0; i < 2; ++i) a[i] = *(const bf16x8*)(ap[i] + k0);
#pragma unroll
        for (int j = 0; j < 2; ++j) { b[j] = *(const bf16x8*)(bp[j] + k0); if (DUAL) b2[j] = *(const bf16x8*)(bp2[j] + k0); }
#pragma unroll
        for (int i = 0; i < 2; ++i)
#pragma unroll
            for (int j = 0; j < 2; ++j) { acc[i][j] = __builtin_amdgcn_mfma_f32_32x32x16_bf16(a[i], b[j], acc[i][j], 0, 0, 0);
                if (DUAL) acc2[i][j] = __builtin_amdgcn_mfma_f32_32x32x16_bf16(a[i], b2[j], acc2[i][j], 0, 0, 0); }
    }
#pragma unroll
    for (int i = 0; i < 2; ++i)
#pragma unroll
        for (int j = 0; j < 2; ++j)
#pragma unroll
            for (int q = 0; q < 16; ++q) { const int row = tm + i * 32 + (q & 3) + 8 * (q >> 2) + 4 * h, col = tn + j * 32 + r;
                if (DUAL) ep(e, row, col, acc[i][j][q], acc2[i][j][q]); else ep(e, row, col, acc[i][j][q], 0.f); }
}
struct EpInproj { const float* b_in; bf16 *Q, *K, *V, *GU, *GV, *GA, *GB;
    __device__ void operator()(int, int row, int col, float v, float) const {
        v += b_in[col < OFF_F ? col : col + 8]; const size_t r = (size_t)row;
        if (col < 512) Q[r * FW + col] = f2bf(v * QSCALE);
        else if (col < 1024) K[r * FW + col - 512] = f2bf(v);
        else if (col < 1536) V[r * FW + col - 1024] = f2bf(v);
        else if (col < 2048) GU[r * GW + col - 1536] = f2bf(gelu_tanh(v));
        else if (col < 2560) GV[r * GW + col - 2048] = f2bf(gelu_tanh(v));
        else if (col < 3584) GA[r * DM + col - 2560] = f2bf(sigmoidf_(v));
        else GB[r * DM + col - 3584] = f2bf(sigmoidf_(v)); } };
struct EpBrA { const bf16* GA; float* TMPF; __device__ void operator()(int, int row, int col, float v, float) const { const size_t i = (size_t)row * DM + col; TMPF[i] = bf2f(GA[i]) * v; } };
struct EpBrB { const bf16* GB; const float* TMPF; bf16* MRG; __device__ void operator()(int, int row, int col, float v, float) const { const size_t i = (size_t)row * DM + col; MRG[i] = f2bf(TMPF[i] + bf2f(GB[i]) * v); } };
struct EpOut { const float* x; const float* b_out; float* out; __device__ void operator()(int, int row, int col, float v, float) const { const size_t i = (size_t)row * DM + col; out[i] = ALPHA * x[i] + v + b_out[col]; } };
struct EpGU { const float* b_gu; bf16* HID; __device__ void operator()(int e, int row, int col, float vg, float vu) const {
        const float* bb = b_gu + (size_t)e * 2 * DFF; const float gate = fminf(vg + bb[col], 7.f); const float up = fminf(fmaxf(vu + bb[DFF + col], -7.f), 7.f);
        HID[(size_t)row * DFF + col] = f2bf((up + 1.f) * (gate * sigmoidf_(1.702f * gate))); } };
struct EpDn { const float* b_dn; const float* ROWG; bf16* Y; __device__ void operator()(int e, int row, int col, float v, float) const { Y[(size_t)row * DM + col] = f2bf((v + b_dn[(size_t)e * DM + col]) * ROWG[row]); } };
struct EpPG { const float* b_pg; bf16* G; __device__ void operator()(int, int row, int col, float v, float) const { G[(size_t)row * DM + col] = f2bf(sigmoidf_(v + b_pg[col])); } };
struct EpPle { const bf16* G; float* out; __device__ void operator()(int, int row, int col, float v, float) const { const size_t i = (size_t)row * DM + col; out[i] = ALPHA * out[i] + v * bf2f(G[i]); } };

extern "C" void kernel_launch(void* const* d_in, const int* in_sizes, int n_in, void* d_out, int out_size, void* d_ws, size_t ws_size, hipStream_t stream) {
    if (n_in != 27 || out_size != T * DM || ws_size < WS_END) { fprintf(stderr, "kernel_launch: unexpected shapes (n_in %d out %d ws %zu)\n", n_in, out_size, ws_size); return; }
    const float* x = (const float*)d_in[0]; const float* p = (const float*)d_in[1]; const float* w_in = (const float*)d_in[2]; const float* b_in = (const float*)d_in[3];
    const float* gln_g = (const float*)d_in[4]; const float* gln_b = (const float*)d_in[5]; const float* w_sp = (const float*)d_in[6]; const float* b_sp = (const float*)d_in[7];
    const float* w_a = (const float*)d_in[8]; const float* w_b = (const float*)d_in[9]; const float* w_o = (const float*)d_in[10]; const float* b_o = (const float*)d_in[11];
    const float* ln1g = (const float*)d_in[12]; const float* ln1b = (const float*)d_in[13]; const float* w_r = (const float*)d_in[14]; const float* b_r = (const float*)d_in[15];
    const float* w_gu = (const float*)d_in[16]; const float* b_gu = (const float*)d_in[17]; const float* w_dn = (const float*)d_in[18]; const float* b_dn = (const float*)d_in[19];
    const float* ln2g = (const float*)d_in[20]; const float* ln2b = (const float*)d_in[21]; const float* w_ple = (const float*)d_in[22]; const float* w_pg = (const float*)d_in[23];
    const float* b_pg = (const float*)d_in[24]; const float* ln3g = (const float*)d_in[25]; const float* ln3b = (const float*)d_in[26];
    unsigned char* ws = (unsigned char*)d_ws; float* out = (float*)d_out;
    bf16 *WIN = (bf16*)(ws + WS_WIN), *WA = (bf16*)(ws + WS_WA), *WB = (bf16*)(ws + WS_WB), *WO = (bf16*)(ws + WS_WO), *WPG = (bf16*)(ws + WS_WPG), *WPLE = (bf16*)(ws + WS_WPLE), *WSP = (bf16*)(ws + WS_WSP);
    bf16 *WGU = (bf16*)(ws + WS_WGU), *WDN = (bf16*)(ws + WS_WDN), *HB = (bf16*)(ws + WS_HB), *PB = (bf16*)(ws + WS_PB);
    float *FLOG = (float*)(ws + WS_FLOG), *CN = (float*)(ws + WS_CN), *TOPG = (float*)(ws + WS_TOPG), *ROWG = (float*)(ws + WS_ROWG);
    int *POS = (int*)(ws + WS_POS), *LIST = (int*)(ws + WS_LIST), *ROWTOK = (int*)(ws + WS_ROWTOK), *TILEE = (int*)(ws + WS_TILEE);
    unsigned* ctl = (unsigned*)(ws + WS_CTL);
    unsigned char* A = ws + WS_A;
    bf16 *XB = (bf16*)(A + A_XB), *Q = (bf16*)(A + A_Q), *K = (bf16*)(A + A_K), *V = (bf16*)(A + A_V), *GU = (bf16*)(A + A_GU), *GV = (bf16*)(A + A_GV), *GA = (bf16*)(A + A_GA), *GB = (bf16*)(A + A_GB);
    bf16 *ATT = (bf16*)(A + A_ATT), *SGU = (bf16*)(A + A_SGU), *MRG = (bf16*)(A + A_MRG), *HID = (bf16*)(A + A_HID), *Y = (bf16*)(A + A_Y), *G = (bf16*)(A + A_G);
    float* TMPF = (float*)(A + A_TMPF);

    hipMemsetAsync(ws + WS_CTL, 0, CTL_BYTES, stream);
    k_convT<1><<<dim3(DINC / 32, DM / 32, 1), 256, 0, stream>>>(w_in, WIN, DM, DIN, 0, 0);
    k_convT<0><<<dim3(DM / 32, FW / 32, 1), 256, 0, stream>>>(w_a, WA, FW, DM, 0, 0);
    k_convT<0><<<dim3(DM / 32, GW / 32, 1), 256, 0, stream>>>(w_b, WB, GW, DM, 0, 0);
    k_convT<0><<<dim3(DM / 32, DM / 32, 1), 256, 0, stream>>>(w_o, WO, DM, DM, 0, 0);
    k_convT<0><<<dim3(DM / 32, DM / 32, 1), 256, 0, stream>>>(w_pg, WPG, DM, DM, 0, 0);
    k_convT<0><<<dim3(DM / 32, PLE / 32, 1), 256, 0, stream>>>(w_ple, WPLE, PLE, DM, 0, 0);
    k_convT<2><<<dim3(2 * DFF / 32, DM / 32, NE), 256, 0, stream>>>(w_gu, WGU, DM, 2 * DFF, (size_t)DM * 2 * DFF, (size_t)DM * 2 * DFF);
    k_convT<0><<<dim3(DM / 32, DFF / 32, NE), 256, 0, stream>>>(w_dn, WDN, DFF, DM, (size_t)DFF * DM, (size_t)DFF * DM);
    k_conv_wsp<<<NGRP * 128 * 128 / 256, 256, 0, stream>>>(w_sp, WSP);
    k_conv_p<<<T * PLE / 1024, 256, 0, stream>>>(p, PB);
    k_prep_x<<<T / 4, 256, 0, stream>>>(x, w_in, b_in, XB, FLOG);
    k_cumsum<<<NB * NH, 256, 0, stream>>>(FLOG, CN);
    { NG g = mkng(XB, DM, nullptr, WIN, DM, DM, nullptr, 0); EpInproj ep{b_in, Q, K, V, GU, GV, GA, GB}; k_ngemm<EpInproj, false><<<dim3(DINC / 128, T / 128), 256, 0, stream>>>(g, ep); }
    k_attn_naive<<<NB * NH * SEQ / 4, 256, 0, stream>>>(Q, K, V, CN, ATT);
    k_sgu_naive<<<NB * 16 * NGRP, 256, 0, stream>>>(GV, GU, gln_g, gln_b, WSP, b_sp, SGU);
    { NG g = mkng(ATT, FW, nullptr, WA, FW, FW, nullptr, 0); EpBrA ep{GA, TMPF}; k_ngemm<EpBrA, false><<<dim3(DM / 128, T / 128), 256, 0, stream>>>(g, ep); }
    { NG g = mkng(SGU, GW, nullptr, WB, GW, GW, nullptr, 0); EpBrB ep{GB, TMPF, MRG}; k_ngemm<EpBrB, false><<<dim3(DM / 128, T / 128), 256, 0, stream>>>(g, ep); }
    { NG g = mkng(MRG, DM, nullptr, WO, DM, DM, nullptr, 0); EpOut ep{x, b_o, out}; k_ngemm<EpOut, false><<<dim3(DM / 128, T / 128), 256, 0, stream>>>(g, ep); }
    k_ln_rows<0><<<T / 4, 256, 0, stream>>>(out, ln1g, ln1b, HB, nullptr, nullptr);
    k_router_naive<<<T / 4, 256, 0, stream>>>(out, w_r, b_r, TOPG, ctl + CW_CNT, LIST);
    k_scatter_naive<<<NTILE256, 256, 0, stream>>>(ctl + CW_CNT, LIST, TOPG, ROWTOK, ROWG, POS, TILEE);
    { NG g = mkng(HB, DM, ROWTOK, WGU, DM, DM, TILEE, (size_t)2 * DFF * DM); EpGU ep{b_gu, HID}; k_ngemm<EpGU, true><<<dim3(DFF / 128, ROWCAP / 128), 256, 0, stream>>>(g, ep); }
    { NG g = mkng(HID, DFF, nullptr, WDN, DFF, DFF, TILEE, (size_t)DM * DFF); EpDn ep{b_dn, ROWG, Y}; k_ngemm<EpDn, false><<<dim3(DM / 128, ROWCAP / 128), 256, 0, stream>>>(g, ep); }
    k_ln_rows<1><<<T / 4, 256, 0, stream>>>(out, ln2g, ln2b, HB, Y, POS);
    { NG g = mkng(HB, DM, nullptr, WPG, DM, DM, nullptr, 0); EpPG ep{b_pg, G}; k_ngemm<EpPG, false><<<dim3(DM / 128, T / 128), 256, 0, stream>>>(g, ep); }
    { NG g = mkng(PB, PLE, nullptr, WPLE, PLE, PLE, nullptr, 0); EpPle ep{G, out}; k_ngemm<EpPle, false><<<dim3(DM / 128, T / 128), 256, 0, stream>>>(g, ep); }
    k_ln_rows<0><<<T / 4, 256, 0, stream>>>(out, ln3g, ln3b, nullptr, nullptr, nullptr);
}
```

```cpp
#include <hip/hip_runtime.h>
#include <cstdio>
#include <cstdint>

typedef unsigned short bf16;
typedef short bf16x8 __attribute__((ext_vector_type(8)));
typedef float f32x4 __attribute__((ext_vector_type(4)));
typedef float f32x16 __attribute__((ext_vector_type(16)));
typedef unsigned u32x2 __attribute__((ext_vector_type(2)));
typedef unsigned u32x4 __attribute__((ext_vector_type(4)));

constexpr int NB = 16, SEQ = 2048, T = NB * SEQ, DM = 1024, NH = 8, HD = 64, FW = 512, GW = 512, CHUNK = 128, NGRP = 8;
constexpr int NE = 32, TOPK = 4, DFF = 1024, PLE = 256;
constexpr int OFF_F = 1536, DIN = 4616, DINC = 4608;
constexpr float LN_EPS = 1e-5f, ALPHA = 1.189207115002721f, LOG2E = 1.4426950408889634f;
constexpr float QSCALE = 0.125f * LOG2E;
constexpr int ROWCAP = 139264;
constexpr int NTILE256 = ROWCAP / 256;

constexpr size_t MiB = 1u << 20;
constexpr size_t WS_CTL = 0, CTL_BYTES = 1 * MiB;
constexpr size_t WS_WIN = 1 * MiB, WS_WA = 10 * MiB, WS_WB = 11 * MiB, WS_WO = 12 * MiB, WS_WPG = 14 * MiB, WS_WPLE = 16 * MiB, WS_WSP = 17 * MiB, WS_WRH = 17 * MiB + 512 * 1024, WS_WRL = 17 * MiB + 768 * 1024;
constexpr size_t WS_FLOG = 18 * MiB, WS_CN = 19 * MiB, WS_TOPG = 20 * MiB, WS_POS = 20 * MiB + 512 * 1024, WS_LIST = 21 * MiB, WS_ROWTOK = 25 * MiB, WS_ROWG = 26 * MiB, WS_TILEE = 27 * MiB;
constexpr size_t WS_PB = 28 * MiB, WS_WGU = 44 * MiB, WS_WDN = 172 * MiB, WS_HB = 236 * MiB, WS_A = 300 * MiB, WS_END = 844 * MiB;
constexpr size_t A_XB = 0, A_Q = 64 * MiB, A_K = 96 * MiB, A_V = 128 * MiB, A_GU = 160 * MiB, A_GV = 192 * MiB, A_GA = 224 * MiB, A_GB = 288 * MiB, A_ATT = 352 * MiB, A_SGU = 384 * MiB, A_MRG = 416 * MiB;
constexpr size_t A_TMPF = 0;
constexpr size_t A_HID = 0, A_Y = 272 * MiB;
constexpr size_t A_G = 0;
constexpr size_t A_HL = 0;
constexpr int CW_CNT = 64;

__device__ __forceinline__ bf16 f2bf(float f) { unsigned u = __builtin_bit_cast(unsigned, f); return (bf16)((u + 0x7fffu + ((u >> 16) & 1u)) >> 16); }
__device__ __forceinline__ float bf2f(bf16 h) { return __builtin_bit_cast(float, (unsigned)h << 16); }
__device__ __forceinline__ unsigned pk2(float lo, float hi) { return (unsigned)f2bf(lo) | ((unsigned)f2bf(hi) << 16); }
__device__ __forceinline__ float sigmoidf_(float v) { return 1.f / (1.f + __expf(-v)); }
__device__ __forceinline__ float gelu_tanh(float v) { const float u = 0.7978845608028654f * (v + 0.044715f * v * v * v); return v / (1.f + __expf(-2.f * u)); }
__device__ __forceinline__ float wave_sum(float v) {
#pragma unroll
    for (int o = 1; o < 64; o <<= 1) v += __shfl_xor(v, o);
    return v;
}
__device__ __forceinline__ float wave_max(float v) {
#pragma unroll
    for (int o = 1; o < 64; o <<= 1) v = fmaxf(v, __shfl_xor(v, o));
    return v;
}

template <int MODE> __device__ __forceinline__ int colmap(int n) {
    if (MODE == 1) return n < OFF_F ? n : n + 8;
    if (MODE == 2) { const int tile = n >> 8, half = (n >> 7) & 1, c = n & 127; return half * DFF + tile * 128 + c; }
    return n;
}
template <int MODE> __global__ void __launch_bounds__(256) k_convT(const float* W, bf16* Wt, int K, int Nsrc, size_t src_stride, size_t dst_stride) {
    __shared__ float tile[32][33];
    W += blockIdx.z * src_stride; Wt += blockIdx.z * dst_stride;
    const int n0 = blockIdx.x * 32, k0 = blockIdx.y * 32, tx = threadIdx.x & 31, ty = threadIdx.x >> 5;
    for (int i = ty; i < 32; i += 8) tile[i][tx] = W[(size_t)(k0 + i) * Nsrc + colmap<MODE>(n0 + tx)];
    __syncthreads();
    for (int i = ty; i < 32; i += 8) Wt[(size_t)(n0 + i) * K + k0 + tx] = f2bf(tile[tx][i]);
}
__global__ void __launch_bounds__(256) k_conv_wsp(const float* w, bf16* o) {
    const int i = blockIdx.x * 256 + threadIdx.x; const int s = i & 127, t = (i >> 7) & 127;
    o[i] = s <= t ? f2bf(w[i]) : (bf16)0;
}
__global__ void __launch_bounds__(256) k_conv_p(const float* p, bf16* o) {
    const size_t i = ((size_t)blockIdx.x * 256 + threadIdx.x) * 4; const f32x4 v = *(const f32x4*)(p + i);
    u32x2 w; w.x = pk2(v[0], v[1]); w.y = pk2(v[2], v[3]); *(u32x2*)(o + i) = w;
}
__global__ void __launch_bounds__(256) k_prep_x(const float* x, const float* w_in, const float* b_in, bf16* XB, float* FLOG) {
    const int t = (blockIdx.x * 256 + threadIdx.x) >> 6, lane = threadIdx.x & 63;
    const float* xr = x + (size_t)t * DM;
    float f0 = 0, f1 = 0, f2 = 0, f3 = 0, f4 = 0, f5 = 0, f6 = 0, f7 = 0;
#pragma unroll
    for (int j = 0; j < 4; ++j) {
        const int k0 = 4 * lane + 256 * j; const f32x4 v = *(const f32x4*)(xr + k0);
        u32x2 w; w.x = pk2(v[0], v[1]); w.y = pk2(v[2], v[3]); *(u32x2*)(XB + (size_t)t * DM + k0) = w;
#pragma unroll
        for (int c = 0; c < 4; ++c) { const float* wr = w_in + (size_t)(k0 + c) * DIN + OFF_F; const f32x4 w0 = *(const f32x4*)wr, w1 = *(const f32x4*)(wr + 4); const float xv = v[c];
            f0 += xv * w0[0]; f1 += xv * w0[1]; f2 += xv * w0[2]; f3 += xv * w0[3]; f4 += xv * w1[0]; f5 += xv * w1[1]; f6 += xv * w1[2]; f7 += xv * w1[3]; }
    }
    f0 = wave_sum(f0); f1 = wave_sum(f1); f2 = wave_sum(f2); f3 = wave_sum(f3); f4 = wave_sum(f4); f5 = wave_sum(f5); f6 = wave_sum(f6); f7 = wave_sum(f7);
    if (lane == 0) { float* o = FLOG + (size_t)t * 8; const float* bb = b_in + OFF_F;
        o[0] = f0 + bb[0]; o[1] = f1 + bb[1]; o[2] = f2 + bb[2]; o[3] = f3 + bb[3]; o[4] = f4 + bb[4]; o[5] = f5 + bb[5]; o[6] = f6 + bb[6]; o[7] = f7 + bb[7]; }
}
__global__ void __launch_bounds__(256) k_cumsum(const float* FLOG, float* CN) {
    __shared__ float part[256];
    const int bh = blockIdx.x, b = bh >> 3, h = bh & 7, tid = threadIdx.x;
    float v[8]; float s = 0.f;
#pragma unroll
    for (int i = 0; i < 8; ++i) { const float f = FLOG[((size_t)b * SEQ + tid * 8 + i) * 8 + h]; s += fminf(f, 0.f) - log1pf(expf(-fabsf(f))); v[i] = s; }
    part[tid] = s; __syncthreads();
    for (int off = 1; off < 256; off <<= 1) { const float tt = tid >= off ? part[tid - off] : 0.f; __syncthreads(); part[tid] += tt; __syncthreads(); }
    const float base = tid ? part[tid - 1] : 0.f;
#pragma unroll
    for (int i = 0; i < 8; ++i) CN[(size_t)bh * SEQ + tid * 8 + i] = (base + v[i]) * LOG2E;
}
__global__ void __launch_bounds__(256) k_attn_naive(const bf16* Q, const bf16* K, const bf16* V, const float* CN, bf16* ATT) {
    const int gw = (blockIdx.x * 256 + threadIdx.x) >> 6, lane = threadIdx.x & 63;
    const int t = gw & (SEQ - 1), h = (gw >> 11) & 7, b = gw >> 14;
    const size_t row = (size_t)b * SEQ + t;
    float q[64];
#pragma unroll
    for (int d = 0; d < 64; d += 8) { const bf16x8 r = *(const bf16x8*)(Q + row * FW + h * HD + d);
#pragma unroll
        for (int i = 0; i < 8; ++i) q[d + i] = bf2f((bf16)r[i]); }
    const float* cn = CN + (size_t)(b * NH + h) * SEQ; const float ct = cn[t];
    float m = -INFINITY, l = 0.f, acc = 0.f;
    for (int s0 = 0; s0 <= t; s0 += 64) {
        const int s = s0 + lane; float logit = -INFINITY;
        if (s <= t) { const bf16* kr = K + ((size_t)b * SEQ + s) * FW + h * HD; float dot = 0.f;
#pragma unroll
            for (int d = 0; d < 64; d += 8) { const bf16x8 r = *(const bf16x8*)(kr + d);
#pragma unroll
                for (int i = 0; i < 8; ++i) dot += q[d + i] * bf2f((bf16)r[i]); }
            logit = dot + (ct - cn[s]); }
        const float mn = fmaxf(m, wave_max(logit));
        const float p = (s <= t) ? exp2f(logit - mn) : 0.f;
        const float sc = exp2f(m - mn);
        l = l * sc + wave_sum(p); acc *= sc;
        const int n = (t - s0 + 1) < 64 ? (t - s0 + 1) : 64;
        for (int j = 0; j < n; ++j) { const float pj = __shfl(p, j); acc += pj * bf2f(V[((size_t)b * SEQ + s0 + j) * FW + h * HD + lane]); }
        m = mn;
    }
    ATT[row * FW + h * HD + lane] = f2bf(acc / l);
}
__global__ void __launch_bounds__(256) k_sgu_naive(const bf16* GV, const bf16* GU, const float* ln_g, const float* ln_b, const bf16* WSP, const float* b_sp, bf16* SGU) {
    __shared__ float vln[128][65];
    const int g = blockIdx.x & 7, n = (blockIdx.x >> 3) & 15, b = blockIdx.x >> 7, tid = threadIdx.x, wave = tid >> 6, lane = tid & 63;
    const size_t row0 = (size_t)b * SEQ + n * CHUNK;
    for (int r = wave; r < 128; r += 4) {
        const bf16x8 raw = *(const bf16x8*)(GV + (row0 + r) * GW + lane * 8); float x[8]; float s = 0.f;
#pragma unroll
        for (int i = 0; i < 8; ++i) { x[i] = bf2f((bf16)raw[i]); s += x[i]; }
        const float mean = wave_sum(s) * (1.f / GW); float s2 = 0.f;
#pragma unroll
        for (int i = 0; i < 8; ++i) { x[i] -= mean; s2 += x[i] * x[i]; }
        const float rstd = 1.f / sqrtf(wave_sum(s2) * (1.f / GW) + LN_EPS);
        if ((lane >> 3) == g) {
#pragma unroll
            for (int i = 0; i < 8; ++i) { const int c = lane * 8 + i; vln[r][c - g * 64] = x[i] * rstd * ln_g[c] + ln_b[c]; } }
    }
    __syncthreads();
    const int t = tid >> 1, dh = (tid & 1) * 32;
    float acc[32];
#pragma unroll
    for (int d = 0; d < 32; ++d) acc[d] = 0.f;
    for (int s = 0; s <= t; ++s) { const float w = bf2f(WSP[(size_t)(g * 128 + t) * 128 + s]);
#pragma unroll
        for (int d = 0; d < 32; ++d) acc[d] += w * vln[s][dh + d]; }
    const float bs = b_sp[g * 128 + t];
#pragma unroll
    for (int d = 0; d < 32; ++d) { const size_t idx = (row0 + t) * GW + g * 64 + dh + d; SGU[idx] = f2bf(bf2f(GU[idx]) * (acc[d] + bs)); }
}
template <int MODE> __global__ void __launch_bounds__(256) k_ln_rows(float* X, const float* g, const float* bta, bf16* XBo, const bf16* Y, const int* POS) {
    const int row = (blockIdx.x * 256 + threadIdx.x) >> 6, lane = threadIdx.x & 63;
    float* xr = X + (size_t)row * DM; f32x4 v[4]; float s = 0.f;
#pragma unroll
    for (int j = 0; j < 4; ++j) v[j] = *(const f32x4*)(xr + 4 * lane + 256 * j);
    if (MODE == 1) {
#pragma unroll
        for (int j = 0; j < 4; ++j) v[j] = v[j] * ALPHA;
#pragma unroll
        for (int k = 0; k < TOPK; ++k) { const bf16* yr = Y + (size_t)POS[row * TOPK + k] * DM;
#pragma unroll
            for (int j = 0; j < 4; ++j) { const u32x2 w = *(const u32x2*)(yr + 4 * lane + 256 * j);
                v[j][0] += bf2f((bf16)(w.x & 0xffff)); v[j][1] += bf2f((bf16)(w.x >> 16)); v[j][2] += bf2f((bf16)(w.y & 0xffff)); v[j][3] += bf2f((bf16)(w.y >> 16)); } }
    }
#pragma unroll
    for (int j = 0; j < 4; ++j) s += (v[j][0] + v[j][1]) + (v[j][2] + v[j][3]);
    const float mean = wave_sum(s) * (1.f / DM); float s2 = 0.f;
#pragma unroll
    for (int j = 0; j < 4; ++j) { v[j] = v[j] - mean; s2 += (v[j][0] * v[j][0] + v[j][1] * v[j][1]) + (v[j][2] * v[j][2] + v[j][3] * v[j][3]); }
    const float rstd = 1.f / sqrtf(wave_sum(s2) * (1.f / DM) + LN_EPS);
#pragma unroll
    for (int j = 0; j < 4; ++j) { const int c = 4 * lane + 256 * j; const f32x4 gg = *(const f32x4*)(g + c), bb = *(const f32x4*)(bta + c);
        const f32x4 o = v[j] * rstd * gg + bb; *(f32x4*)(xr + c) = o;
        if (XBo) { u32x2 w; w.x = pk2(o[0], o[1]); w.y = pk2(o[2], o[3]); *(u32x2*)(XBo + (size_t)row * DM + c) = w; } }
}
__global__ void __launch_bounds__(256) k_router_naive(const float* H1, const float* w_router, const float* b_router, float* TOPG, unsigned* cnt, int* LIST) {
    const int t = (blockIdx.x * 256 + threadIdx.x) >> 6, lane = threadIdx.x & 63, e = lane & 31, half = lane >> 5;
    const float* hr = H1 + (size_t)t * DM + half * 512; const float* wr = w_router + (size_t)(half * 512) * NE + e;
    float acc = 0.f;
#pragma unroll 8
    for (int k = 0; k < 512; ++k) acc += hr[k] * wr[(size_t)k * NE];
    acc += __shfl_xor(acc, 32);
    float cur = acc + b_router[e];
    float v0, v1, v2, v3; int i0, i1, i2, i3;
    { float mx = wave_max(cur); int win = __ffsll((unsigned long long)__ballot(cur == mx)) - 1; v0 = mx; i0 = win; if (e == win) cur = -INFINITY; }
    { float mx = wave_max(cur); int win = __ffsll((unsigned long long)__ballot(cur == mx)) - 1; v1 = mx; i1 = win; if (e == win) cur = -INFINITY; }
    { float mx = wave_max(cur); int win = __ffsll((unsigned long long)__ballot(cur == mx)) - 1; v2 = mx; i2 = win; if (e == win) cur = -INFINITY; }
    { float mx = wave_max(cur); int win = __ffsll((unsigned long long)__ballot(cur == mx)) - 1; v3 = mx; i3 = win; }
    const float e0 = 1.f, e1 = __expf(v1 - v0), e2 = __expf(v2 - v0), e3 = __expf(v3 - v0), inv = 1.f / (e0 + e1 + e2 + e3);
    if (lane < 4) { const int ei = lane == 0 ? i0 : lane == 1 ? i1 : lane == 2 ? i2 : i3; const float gi = (lane == 0 ? e0 : lane == 1 ? e1 : lane == 2 ? e2 : e3) * inv;
        const unsigned pos = atomicAdd(cnt + ei, 1u); LIST[(size_t)ei * T + pos] = t * TOPK + lane; TOPG[t * TOPK + lane] = gi; }
}
__global__ void __launch_bounds__(256) k_scatter_naive(const unsigned* cnt, const int* LIST, const float* TOPG, int* ROWTOK, float* ROWG, int* POS, int* TILEE) {
    const int row = blockIdx.x * 256 + threadIdx.x; int base = 0, e = -1, pos = 0, ce = 0;
    for (int j = 0; j < NE; ++j) { const int c = (int)cnt[j], pc = (c + 255) & ~255; if (e < 0 && row < base + pc) { e = j; pos = row - base; ce = c; } base += pc; }
    if (threadIdx.x == 0) TILEE[blockIdx.x] = e;
    if (e >= 0 && pos < ce) { const int tk = LIST[(size_t)e * T + pos]; ROWTOK[row] = tk >> 2; ROWG[row] = TOPG[tk]; POS[tk] = row; }
    else { ROWTOK[row] = 0; ROWG[row] = 0.f; }
}
struct NG { const bf16* A; const int* rowidx; const bf16* Bt; const int* tile_e; size_t b_stride; int lda, ldb, K, pad; };
static NG mkng(const bf16* A, int lda, const int* rowidx, const bf16* Bt, int ldb, int K, const int* tile_e, size_t b_stride) { NG g; g.A = A; g.rowidx = rowidx; g.Bt = Bt; g.tile_e = tile_e; g.b_stride = b_stride; g.lda = lda; g.ldb = ldb; g.K = K; g.pad = 0; return g; }
template <class Epi, bool DUAL> __global__ void __launch_bounds__(256) k_ngemm(NG g, Epi ep) {
    const int w = threadIdx.x >> 6, lane = threadIdx.x & 63, r = lane & 31, h = lane >> 5;
    const int tm = blockIdx.y * 128 + (w >> 1) * 64, tn = blockIdx.x * 128 + (w & 1) * 64;
    int e = 0; if (g.tile_e) { e = g.tile_e[tm >> 8]; if (e < 0) return; }
    const bf16* Bt = g.Bt + (size_t)e * g.b_stride;
    const bf16* ap[2]; const bf16* bp[2]; const bf16* bp2[2];
#pragma unroll
    for (int i = 0; i < 2; ++i) { const int rr = tm + i * 32 + r; const int ar = g.rowidx ? g.rowidx[rr] : rr; ap[i] = g.A + (size_t)ar * g.lda + 8 * h; }
#pragma unroll
    for (int j = 0; j < 2; ++j) { const int nn = tn + j * 32 + r; const int br = DUAL ? ((nn >> 7) * 256 + (nn & 127)) : nn; bp[j] = Bt + (size_t)br * g.ldb + 8 * h; bp2[j] = bp[j] + (size_t)128 * g.ldb; }
    f32x16 acc[2][2], acc2[2][2];
#pragma unroll
    for (int i = 0; i < 2; ++i)
#pragma unroll
        for (int j = 0; j < 2; ++j) { acc[i][j] = f32x16{}; acc2[i][j] = f32x16{}; }
#pragma unroll 2
    for (int k0 = 0; k0 < g.K; k0 += 16) {
        bf16x8 a[2], b[2], b2[2];
#pragma unroll
        for (int i = 0; i < 2; ++i) a[i] = *(const bf16x8*)(ap[i] + k0);
#pragma unroll
        for (int j = 0; j < 2; ++j) { b[j] = *(const bf16x8*)(bp[j] + k0); if (DUAL) b2[j] = *(const bf16x8*)(bp2[j] + k0); }
#pragma unroll
        for (int i = 0; i < 2; ++i)
#pragma unroll
            for (int j = 0; j < 2; ++j) { acc[i][j] = __builtin_amdgcn_mfma_f32_32x32x16_bf16(a[i], b[j], acc[i][j], 0, 0, 0);
                if (DUAL) acc2[i][j] = __builtin_amdgcn_mfma_f32_32x32x16_bf16(a[i], b2[j], acc2[i][j], 0, 0, 0); }
    }
#pragma unroll
    for (int i = 0; i < 2; ++i)
#pragma unroll
        for (int j = 0; j < 2; ++j)
#pragma unroll
            for (int q = 0; q < 16; ++q) { const int row = tm + i * 32 + (q & 3) + 8 * (q >> 2) + 4 * h, col = tn + j * 32 + r;
                if (DUAL) ep(e, row, col, acc[i][j][q], acc2[i][j][q]); else ep(e, row, col, acc[i][j][q], 0.f); }
}
struct EpInproj { const float* b_in; bf16 *Q, *K, *V, *GU, *GV, *GA, *GB;
    __device__ void operator()(int, int row, int col, float v, float) const {
        v += b_in[col < OFF_F ? col : col + 8]; const size_t r = (size_t)row;
        if (col < 512) Q[r * FW + col] = f2bf(v * QSCALE);
        else if (col < 1024) K[r * FW + col - 512] = f2bf(v);
        else if (col < 1536) V[r * FW + col - 1024] = f2bf(v);
        else if (col < 2048) GU[r * GW + col - 1536] = f2bf(gelu_tanh(v));
        else if (col < 2560) GV[r * GW + col - 2048] = f2bf(gelu_tanh(v));
        else if (col < 3584) GA[r * DM + col - 2560] = f2bf(sigmoidf_(v));
        else GB[r * DM + col - 3584] = f2bf(sigmoidf_(v)); } };
struct EpBrA { const bf16* GA; float* TMPF; __device__ void operator()(int, int row, int col, float v, float) const { const size_t i = (size_t)row * DM + col; TMPF[i] = bf2f(GA[i]) * v; } };
struct EpBrB { const bf16* GB; const float* TMPF; bf16* MRG; __device__ void operator()(int, int row, int col, float v, float) const { const size_t i = (size_t)row * DM + col; MRG[i] = f2bf(TMPF[i] + bf2f(GB[i]) * v); } };
struct EpOut { const float* x; const float* b_out; float* out; __device__ void operator()(int, int row, int col, float v, float) const { const size_t i = (size_t)row * DM + col; out[i] = ALPHA * x[i] + v + b_out[col]; } };
struct EpGU { const float* b_gu; bf16* HID; __device__ void operator()(int e, int row, int col, float vg, float vu) const {
        const float* bb = b_gu + (size_t)e * 2 * DFF; const float gate = fminf(vg + bb[col], 7.f); const float up = fminf(fmaxf(vu + bb[DFF + col], -7.f), 7.f);
        HID[(size_t)row * DFF + col] = f2bf((up + 1.f) * (gate * sigmoidf_(1.702f * gate))); } };
struct EpDn { const float* b_dn; const float* ROWG; bf16* Y; __device__ void operator()(int e, int row, int col, float v, float) const { Y[(size_t)row * DM + col] = f2bf((v + b_dn[(size_t)e * DM + col]) * ROWG[row]); } };
struct EpPG { const float* b_pg; bf16* G; __device__ void operator()(int, int row, int col, float v, float) const { G[(size_t)row * DM + col] = f2bf(sigmoidf_(v + b_pg[col])); } };
struct EpPle { const bf16* G; float* out; __device__ void operator()(int, int row, int col, float v, float) const { const size_t i = (size_t)row * DM + col; out[i] = ALPHA * out[i] + v * bf2f(G[i]); } };

#define LAS __attribute__((address_space(3)))
#define GAS __attribute__((address_space(1)))
typedef GAS unsigned gu32;
#define RLX_AGENT __ATOMIC_RELAXED, __HIP_MEMORY_SCOPE_AGENT
constexpr int NWAVES = 8;
constexpr int RING_BYTES = 131072, LDSCTL_OFF = RING_BYTES, MISC_OFF = LDSCTL_OFF + 320, LDS_BYTES = 147456;

namespace pg8 {
#define PG8_LAS __attribute__((address_space(3)))
constexpr int BM = 256, BK = 64, HALF = 128, HTB = HALF * BK * 2, STAGE_BYTES = 8 * HTB, NXCD = 8, WGM = 8;
__host__ __device__ __forceinline__ int lds_byte(int r, int c) { const int st = (r >> 4) * 2 + (c >> 5), rr = r & 15, cc = c & 31, ob = rr * 64 + cc * 2; return st * 1024 + (ob ^ (((ob >> 9) & 1) << 5)); }
__host__ __device__ __forceinline__ void stage_rc(int b, int& R, int& C) { const int st = b / 1024, sb = b % 1024, swz = sb ^ (((sb >> 9) & 1) << 5); R = (st >> 1) * 16 + swz / 64; C = (st & 1) * 32 + (swz % 64) / 2; }
__host__ __device__ __forceinline__ int perm32(int rho) { const int n = rho >> 4, i = rho & 15; return 8 * (i >> 2) + 4 * n + (i & 3); }

struct Unit { int pm, pn, e; const char* A; const char* B; };

struct DenseOrder {
    int nM, nN, nwg, G, c, K; const char* A; const char* Bt;
    __device__ void init(const void* A_, const void* Bt_, int M, int N, int K_, int G_, int c_) { nM = M / BM; nN = N / BM; nwg = nM * nN; G = G_; c = c_; K = K_; A = (const char*)A_; Bt = (const char*)Bt_; }
    __device__ __forceinline__ bool next(int i, Unit& u) const {
        const long L = (long)i * G + c; if (L >= nwg) return false;
        int wgid = (int)L; { const int q = nwg / NXCD, r = nwg % NXCD, xcd = wgid % NXCD, off = wgid / NXCD; wgid = (xcd < r ? xcd * (q + 1) : r * (q + 1) + (xcd - r) * q) + off; }
        const int nig = WGM * nN, gid = wgid / nig, fm = gid * WGM, gsz = (nM - fm) < WGM ? (nM - fm) : WGM;
        u.pm = fm + ((wgid % nig) % gsz); u.pn = (wgid % nig) / gsz; u.e = 0;
        u.A = A + (size_t)u.pm * BM * K * 2; u.B = Bt + (size_t)u.pn * BM * K * 2; return true;
    }
    __device__ __forceinline__ void a_off(const Unit&, unsigned (&off)[2][2]) const {
#pragma unroll
        for (int i = 0; i < 2; ++i) { int R, C; stage_rc((int)threadIdx.x * 16 + i * 8192, R, C); off[0][i] = (unsigned)(R * K + C) * 2u; off[1][i] = off[0][i] + (unsigned)(HALF * K * 2); }
    }
};
struct MoeOrder {
    const int* tilee; const int* rowtok; const char* A; const char* Bt; size_t estride; int K, NCT, c;
    __device__ __forceinline__ bool next(int i, Unit& u) const {
        const int xcd = c & 7, j = c >> 3, rpx = 32 / NCT, tile = i * (256 / NCT) + xcd * rpx + j / NCT;
        if (tile >= NTILE256) return false;
        const int e = __builtin_amdgcn_readfirstlane(__hip_atomic_load(tilee + tile, RLX_AGENT)); if (e < 0) return false;
        u.pm = tile; u.pn = j % NCT; u.e = e;
        u.A = rowtok ? A : A + (size_t)tile * BM * K * 2; u.B = Bt + (size_t)e * estride + (size_t)u.pn * BM * K * 2; return true;
    }
    __device__ __forceinline__ void a_off(const Unit& u, unsigned (&off)[2][2]) const {
#pragma unroll
        for (int i = 0; i < 2; ++i) { int R, C; stage_rc((int)threadIdx.x * 16 + i * 8192, R, C);
            if (rowtok) { off[0][i] = (unsigned)(rowtok[u.pm * BM + R] * K + C) * 2u; off[1][i] = (unsigned)(rowtok[u.pm * BM + HALF + R] * K + C) * 2u; }
            else { off[0][i] = (unsigned)(R * K + C) * 2u; off[1][i] = off[0][i] + (unsigned)(HALF * K * 2); } }
    }
};

template <class Epi, class Sched, bool ALIGN_EPI>
__device__ __forceinline__ void gemm_phase(PG8_LAS unsigned char* lds, const int K, const Sched& S, const Epi& E) {
    const int tid = threadIdx.x, wid = __builtin_amdgcn_readfirstlane(tid >> 6), lane = tid & 63, wr = wid >> 2, wc = wid & 3, fr = lane & 15, fq = lane >> 4;
    const int nt = K / BK;
    unsigned voffB[2];
#pragma unroll
    for (int i = 0; i < 2; ++i) { int R, C; stage_rc(tid * 16 + i * 8192, R, C); const int Rb = Epi::PERM ? ((R & ~31) + perm32(R & 31)) : R; voffB[i] = (unsigned)(Rb * K + C) * 2u; }
    const size_t kstep = (size_t)(BK * 2);
    const size_t hstep = (size_t)HALF * K * 2;
    const unsigned ldsw = (unsigned)wid * 1024u;
    const int aoff = lds_byte(wr * 64 + fr, fq * 8), boff = lds_byte(wc * 32 + fr, fq * 8);
#define PG8_SA(b, h) (((b) * 2 + (h)) * HTB)
#define PG8_SB(b, h) ((4 + (b) * 2 + (h)) * HTB)
#define PG8_STAGE(bufoff, gbase, voff) do { _Pragma("unroll") for (int _i = 0; _i < 2; ++_i) \
        __builtin_amdgcn_global_load_lds((const unsigned*)((const char*)(gbase) + (voff)[_i]), (PG8_LAS unsigned*)(lds + (bufoff) + ldsw + _i * 8192), 16, 0, 0); } while (0)
#define PG8_LDA(dst, b, h) do { _Pragma("unroll") for (int m = 0; m < 4; ++m) _Pragma("unroll") for (int k = 0; k < 2; ++k) dst[m][k] = *(const PG8_LAS bf16x8*)(lds + PG8_SA(b, h) + aoff + m * 2048 + k * 1024); } while (0)
#define PG8_LDB(dst, b, h) do { _Pragma("unroll") for (int n = 0; n < 2; ++n) _Pragma("unroll") for (int k = 0; k < 2; ++k) dst[n][k] = *(const PG8_LAS bf16x8*)(lds + PG8_SB(b, h) + boff + n * 2048 + k * 1024); } while (0)
#define PG8_MMA(ai, bj, At, Bt) do { __builtin_amdgcn_s_setprio(1); _Pragma("unroll") for (int m = 0; m < 4; ++m) _Pragma("unroll") for (int n = 0; n < 2; ++n) _Pragma("unroll") for (int k = 0; k < 2; ++k) \
        acc[ai][bj][m][n] = __builtin_amdgcn_mfma_f32_16x16x32_bf16(Bt[n][k], At[m][k], acc[ai][bj][m][n], 0, 0, 0); __builtin_amdgcn_s_setprio(0); } while (0)
#define PG8_WAIT_V(n) asm volatile("s_waitcnt vmcnt(" #n ")" ::: "memory")
#define PG8_WAIT_L(n) asm volatile("s_waitcnt lgkmcnt(" #n ")" ::: "memory")
#define PG8_BAR __builtin_amdgcn_s_barrier()
#define PG8_SCHED __builtin_amdgcn_sched_barrier(0)
    Unit cur, nxt; int ui = 0;
    if (!S.next(0, cur)) return;
    f32x4 acc[2][2][4][2];
#pragma unroll
    for (int a = 0; a < 2; ++a)
#pragma unroll
        for (int b = 0; b < 2; ++b)
#pragma unroll
            for (int m = 0; m < 4; ++m)
#pragma unroll
                for (int n = 0; n < 2; ++n) acc[a][b][m][n] = (f32x4){0.f, 0.f, 0.f, 0.f};
    bf16x8 At[4][2], B0[2][2], B1[2][2];
    unsigned cof[2][2], nof[2][2];
    S.a_off(cur, cof);
    const char* cA = cur.A; const char* cB = cur.B;
    PG8_STAGE(PG8_SB(0, 0), cB, voffB); PG8_STAGE(PG8_SB(0, 1), cB + hstep, voffB); PG8_STAGE(PG8_SA(0, 0), cA, cof[0]); PG8_STAGE(PG8_SA(0, 1), cA, cof[1]);
    if (wr == 1) PG8_BAR;
    PG8_WAIT_V(2); PG8_BAR;
    PG8_STAGE(PG8_SB(1, 0), cB + kstep, voffB); PG8_STAGE(PG8_SA(1, 0), cA + kstep, cof[0]); PG8_STAGE(PG8_SB(1, 1), cB + hstep + kstep, voffB);
    PG8_WAIT_V(6); PG8_BAR;
    for (;;) {
        const bool has_next = S.next(ui + 1, nxt);
        const char* nA = has_next ? nxt.A : cA; const char* nB = has_next ? nxt.B : cB;
        if (has_next) S.a_off(nxt, nof); else { nof[0][0] = cof[0][0]; nof[0][1] = cof[0][1]; nof[1][0] = cof[1][0]; nof[1][1] = cof[1][1]; }
        for (int t = 0; t < nt; t += 2) {
            const bool last = (t == nt - 2);
            const char* a1 = cA + (size_t)(t + 1) * kstep;
            const char* a2 = last ? nA : cA + (size_t)(t + 2) * kstep; const char* b2 = last ? nB : cB + (size_t)(t + 2) * kstep;
            const char* a3 = a2 + kstep; const char* b3 = b2 + kstep;
            unsigned s0[2], s1[2]; s0[0] = last ? nof[0][0] : cof[0][0]; s0[1] = last ? nof[0][1] : cof[0][1]; s1[0] = last ? nof[1][0] : cof[1][0]; s1[1] = last ? nof[1][1] : cof[1][1];
            PG8_LDB(B0, 0, 0); PG8_LDB(B1, 0, 1); PG8_SCHED; PG8_LDA(At, 0, 0); PG8_STAGE(PG8_SA(1, 1), a1, cof[1]);
            PG8_WAIT_V(8); PG8_WAIT_L(0); PG8_BAR; PG8_MMA(0, 0, At, B0); PG8_MMA(0, 1, At, B1); PG8_BAR; PG8_SCHED;
            PG8_LDA(At, 0, 1); PG8_STAGE(PG8_SB(0, 0), b2, voffB); PG8_STAGE(PG8_SB(0, 1), b2 + hstep, voffB); PG8_STAGE(PG8_SA(0, 0), a2, s0);
            PG8_WAIT_V(8); PG8_WAIT_L(0); PG8_BAR; PG8_MMA(1, 0, At, B0); PG8_MMA(1, 1, At, B1); PG8_BAR; PG8_SCHED;
            PG8_LDB(B0, 1, 0); PG8_LDB(B1, 1, 1); PG8_SCHED; PG8_LDA(At, 1, 0); PG8_STAGE(PG8_SA(0, 1), a2, s1);
            PG8_WAIT_V(8); PG8_WAIT_L(0); PG8_BAR; PG8_MMA(0, 0, At, B0); PG8_MMA(0, 1, At, B1); PG8_BAR; PG8_SCHED;
            PG8_LDA(At, 1, 1); PG8_STAGE(PG8_SB(1, 0), b3, voffB); PG8_STAGE(PG8_SB(1, 1), b3 + hstep, voffB); PG8_STAGE(PG8_SA(1, 0), a3, s0);
            PG8_WAIT_V(8); PG8_WAIT_L(0); PG8_BAR; PG8_MMA(1, 0, At, B0); PG8_MMA(1, 1, At, B1); PG8_BAR; PG8_SCHED;
        }
        if constexpr (ALIGN_EPI) { if (wr == 0) PG8_BAR; }
        E(acc, cur, wr, wc, fr, fq);
        if (!has_next) break;
#pragma unroll
        for (int a = 0; a < 2; ++a)
#pragma unroll
            for (int b = 0; b < 2; ++b)
#pragma unroll
                for (int m = 0; m < 4; ++m)
#pragma unroll
                    for (int n = 0; n < 2; ++n) acc[a][b][m][n] = (f32x4){0.f, 0.f, 0.f, 0.f};
        cur = nxt; cA = nA; cB = nB; ++ui;
        cof[0][0] = nof[0][0]; cof[0][1] = nof[0][1]; cof[1][0] = nof[1][0]; cof[1][1] = nof[1][1];
        if constexpr (ALIGN_EPI) { if (wr == 1) PG8_BAR; }
    }
    PG8_WAIT_V(0);
    if constexpr (!ALIGN_EPI) { if (wr == 0) PG8_BAR; }
    PG8_BAR;
#undef PG8_SA
#undef PG8_SB
#undef PG8_STAGE
#undef PG8_LDA
#undef PG8_LDB
#undef PG8_MMA
#undef PG8_WAIT_V
#undef PG8_WAIT_L
#undef PG8_BAR
#undef PG8_SCHED
}

__device__ __forceinline__ unsigned cvt_pk_bf16(float lo, float hi) { unsigned r; asm volatile("v_cvt_pk_bf16_f32 %0, %1, %2" : "=v"(r) : "v"(lo), "v"(hi)); return r; }
__device__ __forceinline__ u32x4 pack8(const f32x4 v0, const f32x4 v1) { u32x4 w; w.x = cvt_pk_bf16(v0[0], v0[1]); w.y = cvt_pk_bf16(v0[2], v0[3]); w.z = cvt_pk_bf16(v1[0], v1[1]); w.w = cvt_pk_bf16(v1[2], v1[3]); return w; }
__device__ __forceinline__ float fsigmoid(float v) { return __builtin_amdgcn_rcpf(1.f + __builtin_amdgcn_exp2f(-LOG2E * v)); }
__device__ __forceinline__ float fgelu(float v) { const float z = v * (-2.3022082f - 0.10294324f * v * v); return v * __builtin_amdgcn_rcpf(1.f + __builtin_amdgcn_exp2f(z)); }
__device__ __forceinline__ void unpack8(const u32x4 w, f32x4& a, f32x4& b) {
    a[0] = __builtin_bit_cast(float, w.x << 16); a[1] = __builtin_bit_cast(float, w.x & 0xffff0000u); a[2] = __builtin_bit_cast(float, w.y << 16); a[3] = __builtin_bit_cast(float, w.y & 0xffff0000u);
    b[0] = __builtin_bit_cast(float, w.z << 16); b[1] = __builtin_bit_cast(float, w.z & 0xffff0000u); b[2] = __builtin_bit_cast(float, w.w << 16); b[3] = __builtin_bit_cast(float, w.w & 0xffff0000u); }
#define EPI_ROWS(...) _Pragma("unroll") for (int ai = 0; ai < 2; ++ai) _Pragma("unroll") for (int m = 0; m < 4; ++m) { const size_t row = (size_t)(u.pm * BM + ai * HALF + wr * 64 + m * 16 + fr); __VA_ARGS__ }

struct EpInproj { static constexpr bool PERM = true; const float* b_in; bf16 *Q, *K, *V, *GU, *GV, *GA, *GB;
    __device__ __forceinline__ void operator()(const f32x4 (&acc)[2][2][4][2], const Unit& u, int wr, int wc, int fr, int fq) const {
        const int pn = u.pn; int kind, ld, ct; bf16* dst;
        if (pn < 2) { kind = 0; dst = Q; ld = FW; ct = pn; } else if (pn < 4) { kind = 1; dst = K; ld = FW; ct = pn - 2; } else if (pn < 6) { kind = 1; dst = V; ld = FW; ct = pn - 4; }
        else if (pn < 8) { kind = 2; dst = GU; ld = GW; ct = pn - 6; } else if (pn < 10) { kind = 2; dst = GV; ld = GW; ct = pn - 8; }
        else if (pn < 14) { kind = 3; dst = GA; ld = DM; ct = pn - 10; } else { kind = 3; dst = GB; ld = DM; ct = pn - 14; }
        const int cc = pn * BM, sc = (cc < OFF_F ? cc : cc + 8) + wc * 32 + 8 * fq;
        f32x4 bv[2][2];
_Pragma("unroll")
        for (int bj = 0; bj < 2; ++bj)
_Pragma("unroll")
            for (int n = 0; n < 2; ++n) bv[bj][n] = *(const f32x4*)(b_in + sc + bj * HALF + 4 * n);
        EPI_ROWS( bf16* rowp = dst + row * ld + ct * BM + wc * 32 + 8 * fq;
_Pragma("unroll")
            for (int bj = 0; bj < 2; ++bj) { f32x4 v0 = acc[ai][bj][m][0] + bv[bj][0], v1 = acc[ai][bj][m][1] + bv[bj][1];
                if (kind == 0) { v0 = v0 * QSCALE; v1 = v1 * QSCALE; }
                else if (kind == 2) {
_Pragma("unroll")
                    for (int i = 0; i < 4; ++i) { v0[i] = fgelu(v0[i]); v1[i] = fgelu(v1[i]); } }
                else if (kind == 3) {
_Pragma("unroll")
                    for (int i = 0; i < 4; ++i) { v0[i] = fsigmoid(v0[i]); v1[i] = fsigmoid(v1[i]); } }
                *(u32x4*)(rowp + bj * HALF) = pack8(v0, v1); } )
    } };
struct EpBrA { static constexpr bool PERM = true; const bf16* GA; float* TMPF;
    __device__ __forceinline__ void operator()(const f32x4 (&acc)[2][2][4][2], const Unit& u, int wr, int wc, int fr, int fq) const {
        EPI_ROWS( const size_t o = row * DM + u.pn * BM + wc * 32 + 8 * fq;
_Pragma("unroll")
            for (int bj = 0; bj < 2; ++bj) { f32x4 g0, g1; unpack8(*(const u32x4*)(GA + o + bj * HALF), g0, g1);
                *(f32x4*)(TMPF + o + bj * HALF) = g0 * acc[ai][bj][m][0]; *(f32x4*)(TMPF + o + bj * HALF + 4) = g1 * acc[ai][bj][m][1]; } )
    } };
struct EpBrB { static constexpr bool PERM = true; const bf16* GB; const float* TMPF; bf16* MRG;
    __device__ __forceinline__ void operator()(const f32x4 (&acc)[2][2][4][2], const Unit& u, int wr, int wc, int fr, int fq) const {
        EPI_ROWS( const size_t o = row * DM + u.pn * BM + wc * 32 + 8 * fq;
_Pragma("unroll")
            for (int bj = 0; bj < 2; ++bj) { f32x4 g0, g1; unpack8(*(const u32x4*)(GB + o + bj * HALF), g0, g1);
                const f32x4 t0 = *(const f32x4*)(TMPF + o + bj * HALF), t1 = *(const f32x4*)(TMPF + o + bj * HALF + 4);
                *(u32x4*)(MRG + o + bj * HALF) = pack8(t0 + g0 * acc[ai][bj][m][0], t1 + g1 * acc[ai][bj][m][1]); } )
    } };
struct EpOut { static constexpr bool PERM = false; const float* x; const float* b_out; float* out;
    __device__ __forceinline__ void operator()(const f32x4 (&acc)[2][2][4][2], const Unit& u, int wr, int wc, int fr, int fq) const {
        const int col0 = u.pn * BM + wc * 32 + 4 * fq;
        f32x4 bv[2][2];
_Pragma("unroll")
        for (int bj = 0; bj < 2; ++bj)
_Pragma("unroll")
            for (int n = 0; n < 2; ++n) bv[bj][n] = *(const f32x4*)(b_out + col0 + bj * HALF + n * 16);
        EPI_ROWS( const size_t o = row * DM + col0;
_Pragma("unroll")
            for (int bj = 0; bj < 2; ++bj)
_Pragma("unroll")
                for (int n = 0; n < 2; ++n) { const f32x4 xv = *(const f32x4*)(x + o + bj * HALF + n * 16); *(f32x4*)(out + o + bj * HALF + n * 16) = xv * ALPHA + acc[ai][bj][m][n] + bv[bj][n]; } )
    } };
struct EpGU { static constexpr bool PERM = true; const float* b_gu; bf16* HID;
    __device__ __forceinline__ void operator()(const f32x4 (&acc)[2][2][4][2], const Unit& u, int wr, int wc, int fr, int fq) const {
        const int j0 = u.pn * HALF + wc * 32 + 8 * fq; const float* bb = b_gu + (size_t)u.e * 2 * DFF + j0;
        f32x4 bg[2], bu[2];
_Pragma("unroll")
        for (int n = 0; n < 2; ++n) { bg[n] = *(const f32x4*)(bb + 4 * n); bu[n] = *(const f32x4*)(bb + DFF + 4 * n); }
        EPI_ROWS( f32x4 hv[2];
_Pragma("unroll")
            for (int n = 0; n < 2; ++n) { const f32x4 g = acc[ai][0][m][n] + bg[n], up = acc[ai][1][m][n] + bu[n];
_Pragma("unroll")
                for (int i = 0; i < 4; ++i) { const float gt = fminf(g[i], 7.f), uu = fminf(fmaxf(up[i], -7.f), 7.f); hv[n][i] = (uu + 1.f) * (gt * __builtin_amdgcn_rcpf(1.f + __builtin_amdgcn_exp2f(-1.702f * LOG2E * gt))); } }
            *(u32x4*)(HID + row * DFF + j0) = pack8(hv[0], hv[1]); )
    } };
struct EpDn { static constexpr bool PERM = true; const float* b_dn; const float* ROWG; bf16* Y;
    __device__ __forceinline__ void operator()(const f32x4 (&acc)[2][2][4][2], const Unit& u, int wr, int wc, int fr, int fq) const {
        const int col0 = u.pn * BM + wc * 32 + 8 * fq; const float* bb = b_dn + (size_t)u.e * DM + col0;
        f32x4 bv[2][2];
_Pragma("unroll")
        for (int bj = 0; bj < 2; ++bj)
_Pragma("unroll")
            for (int n = 0; n < 2; ++n) bv[bj][n] = *(const f32x4*)(bb + bj * HALF + 4 * n);
        EPI_ROWS( const float gt = ROWG[row]; bf16* rowp = Y + row * DM + col0;
_Pragma("unroll")
            for (int bj = 0; bj < 2; ++bj) *(u32x4*)(rowp + bj * HALF) = pack8((acc[ai][bj][m][0] + bv[bj][0]) * gt, (acc[ai][bj][m][1] + bv[bj][1]) * gt); )
    } };
struct EpPG { static constexpr bool PERM = true; const float* b_pg; bf16* G;
    __device__ __forceinline__ void operator()(const f32x4 (&acc)[2][2][4][2], const Unit& u, int wr, int wc, int fr, int fq) const {
        const int col0 = u.pn * BM + wc * 32 + 8 * fq;
        f32x4 bv[2][2];
_Pragma("unroll")
        for (int bj = 0; bj < 2; ++bj)
_Pragma("unroll")
            for (int n = 0; n < 2; ++n) bv[bj][n] = *(const f32x4*)(b_pg + col0 + bj * HALF + 4 * n);
        EPI_ROWS( bf16* rowp = G + row * DM + col0;
_Pragma("unroll")
            for (int bj = 0; bj < 2; ++bj) { f32x4 v0 = acc[ai][bj][m][0] + bv[bj][0], v1 = acc[ai][bj][m][1] + bv[bj][1];
_Pragma("unroll")
                for (int i = 0; i < 4; ++i) { v0[i] = fsigmoid(v0[i]); v1[i] = fsigmoid(v1[i]); }
                *(u32x4*)(rowp + bj * HALF) = pack8(v0, v1); } )
    } };
struct EpPle { static constexpr bool PERM = false; const bf16* G; float* out;
    __device__ __forceinline__ void operator()(const f32x4 (&acc)[2][2][4][2], const Unit& u, int wr, int wc, int fr, int fq) const {
        const int col0 = u.pn * BM + wc * 32 + 4 * fq;
        EPI_ROWS( const size_t o = row * DM + col0;
_Pragma("unroll")
            for (int bj = 0; bj < 2; ++bj)
_Pragma("unroll")
                for (int n = 0; n < 2; ++n) { const size_t oo = o + bj * HALF + n * 16; const u32x2 gw = *(const u32x2*)(G + oo); f32x4 g;
                    g[0] = __builtin_bit_cast(float, gw.x << 16); g[1] = __builtin_bit_cast(float, gw.x & 0xffff0000u); g[2] = __builtin_bit_cast(float, gw.y << 16); g[3] = __builtin_bit_cast(float, gw.y & 0xffff0000u);
                    const f32x4 ov = *(const f32x4*)(out + oo); *(f32x4*)(out + oo) = ov * ALPHA + acc[ai][bj][m][n] * g; } )
    } };
}

#include <hip/hip_bf16.h>
#include <cmath>
namespace attn_body {
using bf16=__hip_bfloat16;
using bf16x8=__attribute__((ext_vector_type(8)))short;
using s16x4=__attribute__((ext_vector_type(4)))short;
using f32x16=__attribute__((ext_vector_type(16)))float;
using f32x4=__attribute__((ext_vector_type(4)))float;
using u32x4=__attribute__((ext_vector_type(4)))unsigned;
constexpr int BATCH=16,NHEAD=8,SEQ=2048,D=64,DM=NHEAD*D;
constexpr int NW=8,QBLK=32,QB=QBLK*NW,KVBLK=64,NQB=SEQ/QB;
constexpr int ATTN_PITCH=DM, ATTN_UNIT_ROWS=QB;
__device__ __forceinline__ int crow(int r,int hi){return (r&3)+8*(r>>2)+4*hi;}
#define SBAR() __builtin_amdgcn_sched_barrier(0)
__device__ __forceinline__ void cmask(f32x16&p0,f32x16&p1,int jb,int qrel,int hi){
  const float NEG=-INFINITY; int kb=64*jb+4*hi;
  #pragma unroll
  for(int r=0;r<16;++r){int kv=kb+(r&3)+8*(r>>2); if(kv>qrel)p0[r]=NEG; if(kv+32>qrel)p1[r]=NEG;}
}

constexpr int NSLOT=3, SLOTB=8192;
constexpr int LDS_K=0, LDS_V=NSLOT*SLOTB, LDS_WS=2*NSLOT*SLOTB, LDS_OST=LDS_WS+NW*64*4, LDS_CN=LDS_OST+NW*4096, LDS_BYTES=LDS_CN+SEQ*4;
constexpr float C2=0.125f*1.4426950408889634f;
__device__ __forceinline__ void glds16(const void*gsrc,unsigned lds_dst){unsigned keep;
  asm volatile("s_mov_b32 %0, m0\n\ts_mov_b32 m0, %2\n\ts_nop 0\n\tglobal_load_lds_dwordx4 %1, off\n\ts_mov_b32 m0, %0":"=&s"(keep):"v"(gsrc),"s"(lds_dst):"memory");}
__device__ __forceinline__ float max3f(float a,float b,float c){float r;asm("v_max3_f32 %0, %1, %2, %3":"=v"(r):"v"(a),"v"(b),"v"(c));return r;}
__device__ __forceinline__ float max2f(float a,float b){float r;asm("v_max_f32_e32 %0, %1, %2":"=v"(r):"v"(a),"v"(b));return r;}
__device__ __forceinline__ float fadd_s(float a,float b){float r;asm("v_add_f32_e32 %0, %1, %2":"=v"(r):"v"(a),"v"(b));return r;}
__device__ __forceinline__ float fsub_s(float a,float b){float r;asm("v_sub_f32_e32 %0, %1, %2":"=v"(r):"v"(a),"v"(b));return r;}
typedef float f32x2_t __attribute__((ext_vector_type(2))); typedef __bf16 bf16x2_t __attribute__((ext_vector_type(2)));
__device__ __forceinline__ unsigned cvtpk_s(float lo,float hi){f32x2_t v={lo,hi};bf16x2_t b=__builtin_convertvector(v,bf16x2_t);return __builtin_bit_cast(unsigned,b);}
#define WAIT_BAR(N) asm volatile("s_waitcnt vmcnt(" #N ") lgkmcnt(0)\n\ts_barrier":::"memory")

__device__ __forceinline__ void qkt(f32x16&p0,f32x16&p1,const char*Kslot,const bf16x8*qr,int r32,int hi){
  const char*kb=Kslot+hi*1024+r32*16;
  #pragma unroll
  for(int d0=0;d0<4;++d0){
    const bf16x8 b0=*reinterpret_cast<const bf16x8*>(kb+d0*2048);
    const bf16x8 b1=*reinterpret_cast<const bf16x8*>(kb+d0*2048+512);
    {p0=__builtin_amdgcn_mfma_f32_32x32x16_bf16(b0,qr[d0],p0,0,0,0);p1=__builtin_amdgcn_mfma_f32_32x32x16_bf16(b1,qr[d0],p1,0,0,0);}}
}
typedef __attribute__((address_space(3))) const char* lds_cptr;
typedef short v4i16_t __attribute__((ext_vector_type(4)));
__device__ __forceinline__ void kload8(bf16x8*kf,lds_cptr kp){
  kf[0]=*(const __attribute__((address_space(3))) bf16x8*)(kp);      kf[1]=*(const __attribute__((address_space(3))) bf16x8*)(kp+512);
  kf[2]=*(const __attribute__((address_space(3))) bf16x8*)(kp+2048); kf[3]=*(const __attribute__((address_space(3))) bf16x8*)(kp+2560);
  kf[4]=*(const __attribute__((address_space(3))) bf16x8*)(kp+4096); kf[5]=*(const __attribute__((address_space(3))) bf16x8*)(kp+4608);
  kf[6]=*(const __attribute__((address_space(3))) bf16x8*)(kp+6144); kf[7]=*(const __attribute__((address_space(3))) bf16x8*)(kp+6656);
}
__device__ __forceinline__ void kload2(bf16x8*kf,lds_cptr kp,int j){ kf[2*j]=*(const __attribute__((address_space(3))) bf16x8*)(kp+j*2048); kf[2*j+1]=*(const __attribute__((address_space(3))) bf16x8*)(kp+j*2048+512); }
__device__ __forceinline__ s16x4 vtr(lds_cptr p){ return __builtin_bit_cast(s16x4,__builtin_amdgcn_ds_read_tr16_b64_v4i16((__attribute__((address_space(3))) v4i16_t*)p)); }
__device__ __forceinline__ float rowmax(const f32x16&p0,const f32x16&p1){
  float a=max3f(p0[0],p0[1],p1[0]),b=max3f(p0[2],p0[3],p1[1]);a=max3f(a,p1[2],p1[3]);
  #pragma unroll
  for(int r=4;r<16;r+=4){a=max3f(a,p0[r],p0[r+1]);b=max3f(b,p0[r+2],p0[r+3]);a=max3f(a,p1[r],p1[r+1]);b=max3f(b,p1[r+2],p1[r+3]);}
  const float m=max2f(a,b);
  auto rr=__builtin_amdgcn_permlane32_swap(__float_as_uint(m),__float_as_uint(m),false,false);
  return max2f(__uint_as_float(rr[0]),__uint_as_float(rr[1]));
}
__device__ __forceinline__ void pv(f32x16*o,int vb,bf16x8 pa0,bf16x8 pa1,bf16x8 pa2,bf16x8 pa3){
  #pragma unroll
  for(int d0=0;d0<2;++d0){s16x4 lo[4],hi[4];
    #pragma unroll
    for(int ks=0;ks<4;++ks){
      asm volatile("ds_read_b64_tr_b16 %0,%1 offset:%c2":"=&v"(lo[ks]):"v"(vb),"i"(d0*4096+ks*1024):"memory");
      asm volatile("ds_read_b64_tr_b16 %0,%1 offset:%c2":"=&v"(hi[ks]):"v"(vb),"i"(d0*4096+ks*1024+512):"memory");}
    asm volatile("s_waitcnt lgkmcnt(0)":::"memory");SBAR();
    #define PK(k) (bf16x8){lo[k][0],lo[k][1],lo[k][2],lo[k][3],hi[k][0],hi[k][1],hi[k][2],hi[k][3]}
    o[d0]=__builtin_amdgcn_mfma_f32_32x32x16_bf16(pa0,PK(0),o[d0],0,0,0);
    o[d0]=__builtin_amdgcn_mfma_f32_32x32x16_bf16(pa1,PK(1),o[d0],0,0,0);
    o[d0]=__builtin_amdgcn_mfma_f32_32x32x16_bf16(pa2,PK(2),o[d0],0,0,0);
    o[d0]=__builtin_amdgcn_mfma_f32_32x32x16_bf16(pa3,PK(3),o[d0],0,0,0);
    #undef PK
  }
}

#ifndef ATTN_STORE16
#define ATTN_STORE16(p,v) (*(u32x4*)(p)=(v))
#endif
template<int THRL> __device__ __forceinline__ void attn_unit(int b,int h,int qb,const bf16*Q,const bf16*__restrict__ K,const bf16*__restrict__ V,bf16*O,const float*CNrow,char*shm){
  const int tid=threadIdx.x,lane=tid&63,r32=lane&31,hi=lane>>5; const int wid=__builtin_amdgcn_readfirstlane(tid>>6);
  const long rowbase=(long)b*SEQ; const int q0=qb*QB;
  const bf16*Qw=Q+(rowbase+q0+wid*QBLK)*DM+h*D;
  const bf16*Kh=K+rowbase*DM+h*D,*Vh=V+rowbase*DM+h*D;
  typedef __attribute__((address_space(3))) char* lds_wptr; const lds_wptr shm3=(lds_wptr)shm; const unsigned lds0=(unsigned)(uintptr_t)shm;
  float*wsf=(float*)(shm+LDS_WS)+wid*64;
  const bf16*ksrc=Kh+(long)lane*DM+wid*8;
  const bf16*vsrc=Vh+(long)(16*(wid&3)+(lane>>2))*DM+(wid>>2)*32+(lane&3)*8;
  const unsigned kdst=lds0+LDS_K+wid*1024, vdst=lds0+LDS_V+wid*1024;
  #define DMA_K(t,slot) glds16(ksrc+(long)(t)*KVBLK*DM,(unsigned)__builtin_amdgcn_readfirstlane(kdst+(slot)))
  #define DMA_V(t,slot) glds16(vsrc+(long)(t)*KVBLK*DM,(unsigned)__builtin_amdgcn_readfirstlane(vdst+(slot)))
  const int vb0=(int)(lds0+LDS_V)+((lane>>4)&1)*32+(lane&3)*8+(4*hi+((lane&15)>>2))*64;
  const char*Kbase=shm+LDS_K; bf16x8 kf[8];
  const lds_cptr kp0=shm3+LDS_K+hi*1024+r32*16; const lds_cptr vp0=shm3+LDS_V+((lane>>4)&1)*32+(lane&3)*8+(4*hi+((lane&15)>>2))*64;
  const int NT=(q0+QB)/KVBLK;
  { typedef __attribute__((address_space(3))) f32x4* lds_f4w; const int i4=tid*4; if(i4<q0+QB){ const f32x4 v_=*(const f32x4*)(CNrow+i4); *(lds_f4w)(shm3+LDS_CN+i4*4)=-v_; } asm volatile("s_waitcnt vmcnt(0) lgkmcnt(0)":::"memory"); }
  typedef const __attribute__((address_space(3))) f32x4* lds_f4r;
  #define CINIT(C0,C1,t) do{ const lds_f4r kp_=(lds_f4r)(shm3+LDS_CN+256*(t)+16*hi); _Pragma("unroll") for(int g_=0;g_<4;++g_){ const f32x4 a_=kp_[2*g_], b_=kp_[2*g_+8]; _Pragma("unroll") for(int e_=0;e_<4;++e_){ C0[4*g_+e_]=a_[e_]-mhat; C1[4*g_+e_]=b_[e_]-mhat; } } }while(0)
  DMA_K(0,0);DMA_V(0,0);DMA_K(1,SLOTB);
  bf16x8 qr[4];
  #pragma unroll
  for(int d0=0;d0<4;++d0)qr[d0]=*reinterpret_cast<const bf16x8*>(&Qw[(long)r32*DM+d0*16+hi*8]);
  float mhat=0.f,l_reg=0.f;f32x16 o[2];o[0]=f32x16{};o[1]=f32x16{};
  const int qrel=wid*QBLK+r32;
  #define CMASK(P0,P1,t) do{int jb_=(t)-(NT-4); if(jb_>=0)cmask(P0,P1,jb_,qrel,hi);}while(0)
  bool resc=false;
  #define START(P0,P1) do{ const float rm=rowmax(P0,P1); resc=false; \
    { const float dl=rm; mhat=fadd_s(mhat,dl); \
      _Pragma("unroll") for(int r=0;r<16;++r){P0[r]=fsub_s(P0[r],dl);P1[r]=fsub_s(P1[r],dl);} \
      } \
    _Pragma("unroll") for(int r=0;r<16;++r)P0[r]=__builtin_amdgcn_exp2f(P0[r]); }while(0)
  #define RESC() do{ if(resc){ asm volatile("s_waitcnt lgkmcnt(0)":::"memory"); \
      _Pragma("unroll") for(int d_=0;d_<2;++d_) _Pragma("unroll") for(int r=0;r<16;++r)o[d_][r]*=wsf[crow(r,hi)]; } }while(0)
  f32x16 pA0,pA1,pB0,pB1;
  int sl_prev=0,sl_cur=0,sl_next=SLOTB;
  #define ROT() do{sl_prev=sl_cur;sl_cur=sl_next;sl_next=(sl_next==(NSLOT-1)*SLOTB)?0:sl_next+SLOTB;}while(0)
  DMA_K(2,2*SLOTB);
  WAIT_BAR(3);
  CINIT(pA0,pA1,0); qkt(pA0,pA1,Kbase,qr,r32,hi);asm volatile("s_nop 15\n\ts_nop 7":"+v"(pA0),"+v"(pA1));CMASK(pA0,pA1,0);
  START(pA0,pA1);
  _Pragma("unroll") for(int r=0;r<16;++r)pA1[r]=__builtin_amdgcn_exp2f(pA1[r]);
  WAIT_BAR(0);
  DMA_K(3,0);DMA_V(1,SLOTB);
  ROT();
  kload8(kf,kp0+sl_cur);
  WAIT_BAR(2);
  s16x4 vlo[8],vhi[8]; u32x4 pw0,pw1,pw2,pw3;
  #define PKW(P,B) cvtpk_s(P[B],P[B+1])
  #define PAF(k) __builtin_bit_cast(bf16x8,pw##k)
  #define VFR(i) (bf16x8){vlo[i][0],vlo[i][1],vlo[i][2],vlo[i][3],vhi[i][0],vhi[i][1],vhi[i][2],vhi[i][3]}
  #define PIN(x) asm volatile("":"+v"(x))
  #define MX3(a,b,c) __builtin_fmaxf(__builtin_fmaxf((a),(b)),(c))
  #define GAPA(MF,A0,A1,A2,A3,W0,W1,PW) do{ MF; sacc+=A0; sacc+=A1; sacc+=A2; sacc+=A3; PIN(sacc); W0; W1; PIN(PW); SBAR(); }while(0)
  #define EX(v) __builtin_amdgcn_exp2f(v)
  #define GAPB(MF,X,B) do{ MF; X[B]=EX(X[B]); X[B+1]=EX(X[B+1]); X[B+2]=EX(X[B+2]); X[B+3]=EX(X[B+3]); PIN(X); SBAR(); }while(0)
  #define VRD(i) do{ vlo[i]=vtr(vp_+(((i)>>2)*4096+((i)&3)*1024)); vhi[i]=vtr(vp_+(((i)>>2)*4096+((i)&3)*1024+512)); }while(0)
  #define KRD(G,j) do{ if(G){ kload2(kf,kp0+sl_next,j); SBAR(); } }while(0)
  #define STEP(C0,C1,P0,P1,t,GK,GV,GL) do{ SBAR(); CINIT(C0,C1,t); SBAR(); \
    const lds_cptr vp_=vp0+sl_prev; \
    VRD(0); SBAR(); float sacc=(P0[0]+P0[1]); \
    GAPA(C0=__builtin_amdgcn_mfma_f32_32x32x16_bf16(kf[0],qr[0],C0,0,0,0), P0[2],P0[3],P0[4],P0[5],     pw0[0]=PKW(P0,0), pw0[1]=PKW(P0,2), pw0); \
    VRD(4); SBAR(); GAPA(C1=__builtin_amdgcn_mfma_f32_32x32x16_bf16(kf[1],qr[0],C1,0,0,0), P0[6],P0[7],P0[8],P0[9],     pw0[2]=PKW(P0,4), pw0[3]=PKW(P0,6), pw0); \
    VRD(1); SBAR(); GAPA(C0=__builtin_amdgcn_mfma_f32_32x32x16_bf16(kf[2],qr[1],C0,0,0,0),   P0[10],P0[11],P0[12],P0[13], pw1[0]=PKW(P0,8), pw1[1]=PKW(P0,10), pw1); \
    VRD(5); SBAR(); GAPA(C1=__builtin_amdgcn_mfma_f32_32x32x16_bf16(kf[3],qr[1],C1,0,0,0),   P0[14],P0[15],P1[0],P1[1],   pw1[2]=PKW(P0,12),pw1[3]=PKW(P0,14), pw1); \
    VRD(2); SBAR(); GAPA(C0=__builtin_amdgcn_mfma_f32_32x32x16_bf16(kf[4],qr[2],C0,0,0,0),   P1[2],P1[3],P1[4],P1[5],     pw2[0]=PKW(P1,0), pw2[1]=PKW(P1,2), pw2); \
    VRD(6); SBAR(); GAPA(C1=__builtin_amdgcn_mfma_f32_32x32x16_bf16(kf[5],qr[2],C1,0,0,0),   P1[6],P1[7],P1[8],P1[9],     pw2[2]=PKW(P1,4), pw2[3]=PKW(P1,6), pw2); \
    VRD(3); SBAR(); GAPA(C0=__builtin_amdgcn_mfma_f32_32x32x16_bf16(kf[6],qr[3],C0,0,0,0),   P1[10],P1[11],P1[12],P1[13], pw3[0]=PKW(P1,8), pw3[1]=PKW(P1,10), pw3); \
    VRD(7); SBAR(); GAPA(C1=__builtin_amdgcn_mfma_f32_32x32x16_bf16(kf[7],qr[3],C1,0,0,0),   P1[14],P1[15],0.f,0.f,       pw3[2]=PKW(P1,12),pw3[3]=PKW(P1,14), pw3); \
    l_reg+=sacc; \
    if(GK){DMA_K((t)+3,sl_cur);} if(GV){DMA_V((t)+1,sl_next);} \
    CMASK(C0,C1,t); \
    { float a=MX3(C0[0],C0[1],C1[0]),b=MX3(C0[2],C0[3],C1[1]); a=MX3(a,C1[2],C1[3]); \
      _Pragma("unroll") for(int r=4;r<16;r+=4){a=MX3(a,C0[r],C0[r+1]);b=MX3(b,C0[r+2],C0[r+3]);a=MX3(a,C1[r],C1[r+1]);b=MX3(b,C1[r+2],C1[r+3]);} \
      float rm=__builtin_fmaxf(a,b); { auto rr=__builtin_amdgcn_permlane32_swap(__float_as_uint(rm),__float_as_uint(rm),false,false); rm=__builtin_fmaxf(__uint_as_float(rr[0]),__uint_as_float(rr[1])); } \
      resc=false; \
      if(__builtin_expect(__any(rm>(float)THRL),0)){ const float dl=__builtin_fmaxf(rm,0.f); mhat+=dl; \
        _Pragma("unroll") for(int r=0;r<16;++r){C0[r]-=dl;C1[r]-=dl;} \
        const float f=__builtin_amdgcn_exp2f(-dl); l_reg*=f; if(hi==0)wsf[r32]=f; resc=true; } } \
    SBAR(); \
    GAPB(o[0]=__builtin_amdgcn_mfma_f32_32x32x16_bf16(PAF(0),VFR(0),o[0],0,0,0), C0,0); \
    GAPB(o[1]=__builtin_amdgcn_mfma_f32_32x32x16_bf16(PAF(0),VFR(4),o[1],0,0,0), C0,4); \
    KRD(GL,0); GAPB(o[0]=__builtin_amdgcn_mfma_f32_32x32x16_bf16(PAF(1),VFR(1),o[0],0,0,0), C0,8); \
    KRD(GL,1); GAPB(o[1]=__builtin_amdgcn_mfma_f32_32x32x16_bf16(PAF(1),VFR(5),o[1],0,0,0), C0,12); \
    KRD(GL,2); GAPB(o[0]=__builtin_amdgcn_mfma_f32_32x32x16_bf16(PAF(2),VFR(2),o[0],0,0,0), C1,0); \
    KRD(GL,3); GAPB(o[1]=__builtin_amdgcn_mfma_f32_32x32x16_bf16(PAF(2),VFR(6),o[1],0,0,0), C1,4); \
    GAPB(o[0]=__builtin_amdgcn_mfma_f32_32x32x16_bf16(PAF(3),VFR(3),o[0],0,0,0), C1,8); \
    GAPB(o[1]=__builtin_amdgcn_mfma_f32_32x32x16_bf16(PAF(3),VFR(7),o[1],0,0,0), C1,12); \
    }while(0)
  int t=1;
  #undef CMASK
  #define CMASK(P0,P1,t) do{}while(0)
  for(;t+5<NT;t+=2){
    STEP(pB0,pB1,pA0,pA1,t,true,true,true);     WAIT_BAR(2); RESC(); ROT();
    STEP(pA0,pA1,pB0,pB1,t+1,true,true,true);   WAIT_BAR(2); RESC(); ROT();
  }
  #undef CMASK
  #define CMASK(P0,P1,t) do{int jb_=(t)-(NT-4); if(jb_>=0)cmask(P0,P1,jb_,qrel,hi);}while(0)
  #define ENDW(tt) do{ if((tt)+3<NT){WAIT_BAR(2);} else if((tt)+2<NT){WAIT_BAR(1);} else {WAIT_BAR(0);} }while(0)
  for(;t+1<NT;t+=2){
    STEP(pB0,pB1,pA0,pA1,t,(t+3<NT),(t+1<NT),(t+1<NT));       ENDW(t);   RESC(); ROT();
    STEP(pA0,pA1,pB0,pB1,t+1,(t+4<NT),(t+2<NT),(t+2<NT));     ENDW(t+1); RESC(); ROT();
  }
  STEP(pB0,pB1,pA0,pA1,NT-1,false,false,false); RESC();
  { float sacc=pB0[0]+pB0[1]; _Pragma("unroll") for(int r=2;r<16;++r)sacc+=pB0[r]; _Pragma("unroll") for(int r=0;r<16;++r)sacc+=pB1[r]; l_reg+=sacc;
    pw0=(u32x4){PKW(pB0,0),PKW(pB0,2),PKW(pB0,4),PKW(pB0,6)};pw1=(u32x4){PKW(pB0,8),PKW(pB0,10),PKW(pB0,12),PKW(pB0,14)};pw2=(u32x4){PKW(pB1,0),PKW(pB1,2),PKW(pB1,4),PKW(pB1,6)};pw3=(u32x4){PKW(pB1,8),PKW(pB1,10),PKW(pB1,12),PKW(pB1,14)};
    SBAR(); pv(o,vb0+sl_cur,PAF(0),PAF(1),PAF(2),PAF(3)); }
  #undef PKW
  #undef PAF
  #undef VFR
  #undef PIN
  #undef MX3
  #undef GAPA
  #undef GAPB
  #undef EX
  #undef VRD
  #undef KRD
  #undef STEP
  #undef ENDW
  {auto rr=__builtin_amdgcn_permlane32_swap(__float_as_uint(l_reg),__float_as_uint(l_reg),false,false);l_reg=__uint_as_float(rr[0])+__uint_as_float(rr[1]);}
  if(hi==0)wsf[32+r32]=l_reg;asm volatile("s_waitcnt lgkmcnt(0)":::"memory");
  float rli[16];
  #pragma unroll
  for(int r=0;r<16;++r)rli[r]=__builtin_amdgcn_rcpf(wsf[32+crow(r,hi)]);
  bf16*Ow=O+(rowbase+q0+wid*QBLK)*DM+h*D;
  { bf16*stg=(bf16*)(shm+LDS_OST)+wid*2048;
    #pragma unroll
    for(int r=0;r<16;++r){const int orow=crow(r,hi);
      #pragma unroll
      for(int d0=0;d0<2;++d0)stg[orow*64+d0*32+r32]=__float2bfloat16(o[d0][r]*rli[r]);}
    asm volatile("s_waitcnt lgkmcnt(0)":::"memory");
    #pragma unroll
    for(int i=0;i<4;++i){const int row=i*8+(lane>>3),ch=lane&7; const u32x4 v=*(const u32x4*)(stg+row*64+ch*8); ATTN_STORE16(Ow+(long)row*DM+ch*8,v);} }
  asm volatile("s_waitcnt lgkmcnt(0)\n\ts_barrier":::"memory");
  #undef DMA_K
  #undef CINIT
  #undef DMA_V
  #undef CMASK
  #undef START
  #undef RESC
  #undef ROT
}
constexpr int ATTN_LDS_BYTES=LDS_BYTES;
struct AttnTensors { const bf16* Q; const bf16* K; const bf16* V; bf16* O; const float* CN; };
struct AttnUnit { int bh; int qb; };
struct StaticOrder {
  int vcu;
  __device__ __forceinline__ explicit StaticOrder(int grid,int block):vcu((block%8)*(grid/8)+block/8){}
  __device__ __forceinline__ bool next(int i,AttnUnit&u)const{ if(i>=4)return false; const int s=2*(vcu&1)+(i>>1); u.bh=vcu>>1; u.qb=(i&1)?7-s:s; return true; }
};
template<class Sched,int THRL=8> __device__ __forceinline__ void attn_phase(char*lds,const AttnTensors&T,const Sched&S){
  AttnUnit u;
  for(int i=0;S.next(i,u);++i){ attn_unit<THRL>(u.bh/NHEAD,u.bh%NHEAD,u.qb,T.Q,T.K,T.V,T.O,T.CN+(size_t)u.bh*SEQ,lds); }
}
#undef SBAR
#undef WAIT_BAR
}

#define XB_TMO      128
#define XB_XCNT(j)  (256  + 64 * (j))
#define XB_XSUB(j)  (1280 + 64 * (j))
#define XB_XGEN(j)  (2304 + 64 * (j))
#define XB_TOP      3328
#define XB_TOPGEN   3392
#define XCD_BAR_WORDS 3456
#define XB_SPIN_CAP (1u << 18)
__device__ __forceinline__ unsigned xb_ld(unsigned* p)              { return __hip_atomic_load(p, __ATOMIC_RELAXED, __HIP_MEMORY_SCOPE_AGENT); }
__device__ __forceinline__ unsigned xb_add(unsigned* p, unsigned v) { return __hip_atomic_fetch_add(p, v, __ATOMIC_RELAXED, __HIP_MEMORY_SCOPE_AGENT); }
__device__ __forceinline__ unsigned xb_xcc_id() { return (unsigned)__builtin_amdgcn_s_getreg((3 << 11) | 20) & 0xFu; }
#define XB_SPIN(cond, bar) do { unsigned _sp = 0; while (cond) { __builtin_amdgcn_s_sleep(1); \
    if ((++_sp & 255u) == 0u) { if (xb_ld(&(bar)[XB_TMO])) break; if (_sp > XB_SPIN_CAP) { atomicAdd(&(bar)[XB_TMO], 1u); break; } } } } while (0)
struct XcdBarrier { unsigned* bar; unsigned x; volatile LAS unsigned* st; };
__device__ __forceinline__ XcdBarrier xcd_barrier_post(unsigned* bar, volatile LAS unsigned* st) {
    XcdBarrier b; b.bar = bar; b.x = xb_xcc_id(); b.st = st;
    if (threadIdx.x == 0) (void)xb_add(&bar[XB_XCNT(b.x)], 1u);
    return b;
}
__device__ __forceinline__ void xcd_barrier_complete(unsigned* bar, unsigned x, unsigned& nloc, unsigned& nx) {
    const unsigned G = gridDim.x * gridDim.y * gridDim.z;
    unsigned sum, cnt, mine, sp = 0u;
    for (;;) {
        sum = 0u; cnt = 0u; mine = 0u;
#pragma unroll
        for (unsigned j = 0; j < 16; ++j) { const unsigned c = xb_ld(&bar[XB_XCNT(j)]); sum += c; cnt += (c > 0u) ? 1u : 0u; mine = (j == x) ? c : mine; }
        if (sum == G) break;
        __builtin_amdgcn_s_sleep(1);
        if ((++sp & 255u) == 0u) { if (xb_ld(&bar[XB_TMO])) break; if (sp > XB_SPIN_CAP) { atomicAdd(&bar[XB_TMO], 1u); break; } }
    }
    nloc = mine > 0u ? mine : 1u; nx = cnt > 0u ? cnt : 1u;
}
__device__ __forceinline__ void xcd_barrier(const XcdBarrier& b) {
    asm volatile("s_waitcnt vmcnt(0)" ::: "memory");
    __syncthreads();
    if (threadIdx.x == 0) {
        unsigned* bar = b.bar;
        __builtin_amdgcn_s_waitcnt(0);
        unsigned nloc = b.st[0], nx = b.st[1];
        if (nloc == 0u) { xcd_barrier_complete(bar, b.x, nloc, nx); b.st[0] = nloc; b.st[1] = nx; }
        const unsigned old = xb_add(&bar[XB_XSUB(b.x)], 1u);
        const unsigned gen = old / nloc;
        if (old + 1u == (gen + 1u) * nloc) {
            __builtin_amdgcn_fence(__ATOMIC_RELEASE, "agent");
            asm volatile("s_waitcnt vmcnt(0)" ::: "memory");
            const unsigned og = xb_add(&bar[XB_TOP], 1u);
            const unsigned tg = og / nx;
            if (og + 1u == (tg + 1u) * nx) xb_add(&bar[XB_TOPGEN], 1u);
            else XB_SPIN(xb_ld(&bar[XB_TOPGEN]) == tg, bar);
            __builtin_amdgcn_fence(__ATOMIC_ACQUIRE, "agent");
            xb_add(&bar[XB_XGEN(b.x)], 1u);
            asm volatile("s_waitcnt vmcnt(0)" ::: "memory");
        } else {
            XB_SPIN(xb_ld(&bar[XB_XGEN(b.x)]) == gen, bar);
            __builtin_amdgcn_fence(__ATOMIC_ACQUIRE, "agent");
            asm volatile("s_waitcnt vmcnt(0)" ::: "memory");
        }
    }
    __syncthreads();
}

constexpr int CW_BAR = 4096;
constexpr int N_BAR_REGIONS = 16;
static_assert((CW_BAR + N_BAR_REGIONS * XCD_BAR_WORDS) * 4 <= (int)CTL_BYTES, "CTL words inside the memset region");
constexpr int SGU_ST_OFF = 98304;
static_assert(attn_body::LDS_BYTES <= SGU_ST_OFF && SGU_ST_OFF + 1024 <= RING_BYTES, "LDS map");
#define LDS_WAIT() asm volatile("s_waitcnt lgkmcnt(0)" ::: "memory")

struct MArgs { const float* in[27]; float* out; unsigned char* ws; int ph_lo, ph_hi, li, pad; };
struct Frame {
    LAS unsigned char* lds; int tid, lane, wave, G, vcu;
    const float *x, *p, *w_in, *b_in, *gln_g, *gln_b, *w_sp, *b_sp, *w_a, *w_b, *w_o, *b_o, *ln1g, *ln1b, *w_r, *b_r, *w_gu, *b_gu, *w_dn, *b_dn, *ln2g, *ln2b, *w_ple, *w_pg, *b_pg, *ln3g, *ln3b;
    float* out; unsigned* ctl;
    bf16 *WIN, *WA, *WB, *WO, *WPG, *WPLE, *WSP, *WRH, *WRL, *WGU, *WDN, *HB, *PB;
    float *FLOG, *CN, *TOPG, *ROWG; int *POS, *LIST, *ROWTOK, *TILEE;
    bf16 *XB, *Q, *K, *V, *GU, *GV, *GA, *GB, *ATT, *SGU, *MRG, *HID, *Y, *HL; float* TMPF;
};

template <int MODE> __device__ __forceinline__ void tr_item(const float* W, int K, int Nsrc, bf16* WT, LAS float* scr, int kb, int nb, int lane) {
    const int k0 = 64 * kb, n0 = 32 * nb, cs = colmap<MODE>(n0);
#pragma unroll 8
    for (int i = 0; i < 32; ++i) { const int kk = 2 * i + (lane >> 5); scr[kk * 33 + (lane & 31)] = W[(size_t)(k0 + kk) * Nsrc + cs + (lane & 31)]; }
    LDS_WAIT(); asm volatile("" ::: "memory");
    const int c = lane & 7;
#pragma unroll
    for (int j = 0; j < 4; ++j) { const int n = (lane >> 3) + 8 * j; const LAS float* s = scr + (8 * c) * 33 + n;
        u32x4 o; o.x = pk2(s[0 * 33], s[1 * 33]); o.y = pk2(s[2 * 33], s[3 * 33]); o.z = pk2(s[4 * 33], s[5 * 33]); o.w = pk2(s[6 * 33], s[7 * 33]);
        *(u32x4*)(WT + (size_t)(n0 + n) * K + k0 + 8 * c) = o; }
    LDS_WAIT(); asm volatile("" ::: "memory");
}
template <int MODE> __device__ __forceinline__ void tr_matrix(const float* W, int K, int Nsrc, int Nout, int nbatch, bf16* WT, LAS float* scr, int gw, int NGW, int& rot, int lane) {
    const int nkb = K / 64, nnb = Nout / 32, per = nkb * nnb, total = per * nbatch;
    int first = gw - rot; if (first < 0) first += NGW;
    for (int it = first; it < total; it += NGW) { const int b = it / per, r = it % per;
        tr_item<MODE>(W + (size_t)b * K * Nsrc, K, Nsrc, WT + (size_t)b * Nout * K, scr, r / nnb, r % nnb, lane); }
    rot = (rot + total) % NGW;
}
__device__ __forceinline__ float log_sigmoid(float f) { return fminf(f, 0.f) - log1pf(expf(-fabsf(f))); }

__device__ __forceinline__ void p0_prologue(Frame& F) {
    LAS float* scr = (LAS float*)(F.lds + F.wave * 16384);
    const int gw = F.vcu * NWAVES + F.wave, NGW = F.G * NWAVES, lane = F.lane; int rot = 0;
    tr_matrix<2>(F.w_gu, DM, 2 * DFF, 2 * DFF, NE, F.WGU, scr, gw, NGW, rot, lane);
    tr_matrix<0>(F.w_dn, DFF, DM, DM, NE, F.WDN, scr, gw, NGW, rot, lane);
    tr_matrix<1>(F.w_in, DM, DIN, DINC, 1, F.WIN, scr, gw, NGW, rot, lane);
    tr_matrix<0>(F.w_a, FW, DM, DM, 1, F.WA, scr, gw, NGW, rot, lane);
    tr_matrix<0>(F.w_b, GW, DM, DM, 1, F.WB, scr, gw, NGW, rot, lane);
    tr_matrix<0>(F.w_o, DM, DM, DM, 1, F.WO, scr, gw, NGW, rot, lane);
    tr_matrix<0>(F.w_pg, DM, DM, DM, 1, F.WPG, scr, gw, NGW, rot, lane);
    tr_matrix<0>(F.w_ple, PLE, DM, DM, 1, F.WPLE, scr, gw, NGW, rot, lane);
    const int gt = F.vcu * (NWAVES * 64) + F.tid, NGT = F.G * NWAVES * 64;
    for (int i = gt; i < NGRP * CHUNK * CHUNK; i += NGT) { const int s = i & 127, t = (i >> 7) & 127; F.WSP[i] = s <= t ? f2bf(F.w_sp[i]) : (bf16)0; }
    for (int i = gt; i < NE * DM; i += NGT) { const int e = i >> 10, k = i & 1023; const float w = F.w_r[(size_t)k * NE + e]; const bf16 hi = f2bf(w); F.WRH[i] = hi; F.WRL[i] = f2bf(w - bf2f(hi)); }
    for (size_t i = (size_t)gt * 4; i < (size_t)T * PLE; i += (size_t)NGT * 4) { const f32x4 v = *(const f32x4*)(F.p + i); u32x2 w; w.x = pk2(v[0], v[1]); w.y = pk2(v[2], v[3]); *(u32x2*)(F.PB + i) = w; }
    for (int t = gw; t < T; t += NGW) {
        const float* xr = F.x + (size_t)t * DM; float f0 = 0, f1 = 0, f2 = 0, f3 = 0, f4 = 0, f5 = 0, f6 = 0, f7 = 0;
#pragma unroll
        for (int j = 0; j < 4; ++j) { const int k0 = 4 * lane + 256 * j; const f32x4 v = *(const f32x4*)(xr + k0);
            u32x2 w; w.x = pk2(v[0], v[1]); w.y = pk2(v[2], v[3]); *(u32x2*)(F.XB + (size_t)t * DM + k0) = w;
#pragma unroll
            for (int c = 0; c < 4; ++c) { const float* wr = F.w_in + (size_t)(k0 + c) * DIN + OFF_F; const f32x4 w0 = *(const f32x4*)wr, w1 = *(const f32x4*)(wr + 4); const float xv = v[c];
                f0 += xv * w0[0]; f1 += xv * w0[1]; f2 += xv * w0[2]; f3 += xv * w0[3]; f4 += xv * w1[0]; f5 += xv * w1[1]; f6 += xv * w1[2]; f7 += xv * w1[3]; } }
        f0 = wave_sum(f0); f1 = wave_sum(f1); f2 = wave_sum(f2); f3 = wave_sum(f3); f4 = wave_sum(f4); f5 = wave_sum(f5); f6 = wave_sum(f6); f7 = wave_sum(f7);
        if (lane == 0) { float* o = F.FLOG + (size_t)t * 8; const float* bb = F.b_in + OFF_F;
            *(f32x4*)o = (f32x4){f0 + bb[0], f1 + bb[1], f2 + bb[2], f3 + bb[3]}; *(f32x4*)(o + 4) = (f32x4){f4 + bb[4], f5 + bb[5], f6 + bb[6], f7 + bb[7]}; }
    }
}
__device__ __forceinline__ void p1_cumsum(Frame& F) {
    if (blockIdx.x < NB * NH) {
        LAS float* part = (LAS float*)F.lds; const int bh = blockIdx.x, b = bh >> 3, h = bh & 7, tid = F.tid;
        float v0, v1, v2, v3; { const float* fp = F.FLOG + ((size_t)b * SEQ + tid * 4) * 8 + h; v0 = log_sigmoid(fp[0]); v1 = v0 + log_sigmoid(fp[8]); v2 = v1 + log_sigmoid(fp[16]); v3 = v2 + log_sigmoid(fp[24]); }
        part[tid] = v3; __syncthreads();
        for (int off = 1; off < 512; off <<= 1) { const float tt = tid >= off ? part[tid - off] : 0.f; __syncthreads(); part[tid] += tt; __syncthreads(); }
        const float base = tid ? part[tid - 1] : 0.f;
        *(f32x4*)(F.CN + (size_t)bh * SEQ + tid * 4) = (f32x4){(base + v0) * LOG2E, (base + v1) * LOG2E, (base + v2) * LOG2E, (base + v3) * LOG2E};
    }
    __syncthreads();
}
__device__ __forceinline__ void sgu_unit(Frame& F, int b, int n) {
    typedef float f32x2v __attribute__((ext_vector_type(2)));
    LAS f32x2v* ST = (LAS f32x2v*)(F.lds + SGU_ST_OFF);
    const size_t row0 = (size_t)b * SEQ + (size_t)n * CHUNK; const int lane = F.lane;
    for (int r = F.wave * 16; r < F.wave * 16 + 16; ++r) {
        const bf16x8 raw = *(const bf16x8*)(F.GV + (row0 + r) * GW + lane * 8); float x[8]; float s = 0.f;
#pragma unroll
        for (int i = 0; i < 8; ++i) { x[i] = bf2f((bf16)raw[i]); s += x[i]; }
        const float mean = wave_sum(s) * (1.f / GW); float s2 = 0.f;
#pragma unroll
        for (int i = 0; i < 8; ++i) { const float d = x[i] - mean; s2 += d * d; }
        const float rstd = 1.f / sqrtf(wave_sum(s2) * (1.f / GW) + LN_EPS);
        if (lane == 0) ST[r] = (f32x2v){mean, rstd};
    }
    __syncthreads();
    const int g = F.wave, r = lane & 31, h = lane >> 5;
    f32x16 acc[4][2];
#pragma unroll
    for (int ti = 0; ti < 4; ++ti) { acc[ti][0] = f32x16{}; acc[ti][1] = f32x16{}; }
    const bf16* Wg = F.WSP + (size_t)g * CHUNK * CHUNK;
    const float ga0 = F.gln_g[g * 64 + r], be0 = F.gln_b[g * 64 + r], ga1 = F.gln_g[g * 64 + 32 + r], be1 = F.gln_b[g * 64 + 32 + r];
#pragma unroll
    for (int ks = 0; ks < 8; ++ks) {
        bf16x8 b0, b1;
        const bf16* gp = F.GV + (row0 + 16 * ks + 8 * h) * GW + g * 64 + r;
#pragma unroll
        for (int j = 0; j < 8; ++j) { const f32x2v st = ST[16 * ks + 8 * h + j];
            const float x0 = bf2f(gp[(size_t)j * GW]), x1 = bf2f(gp[(size_t)j * GW + 32]);
            b0[j] = (short)f2bf((x0 - st.x) * st.y * ga0 + be0); b1[j] = (short)f2bf((x1 - st.x) * st.y * ga1 + be1); }
#pragma unroll
        for (int ti = 0; ti < 4; ++ti) if (ti >= (ks >> 1)) {
            const bf16x8 a = *(const bf16x8*)(Wg + (size_t)(ti * 32 + r) * CHUNK + 16 * ks + 8 * h);
            acc[ti][0] = __builtin_amdgcn_mfma_f32_32x32x16_bf16(a, b0, acc[ti][0], 0, 0, 0);
            acc[ti][1] = __builtin_amdgcn_mfma_f32_32x32x16_bf16(a, b1, acc[ti][1], 0, 0, 0); }
    }
#pragma unroll
    for (int ti = 0; ti < 4; ++ti)
#pragma unroll
        for (int q = 0; q < 16; ++q) { const int t = ti * 32 + (q & 3) + 8 * (q >> 2) + 4 * h; const float bs = F.b_sp[g * CHUNK + t]; const size_t idx = (row0 + t) * GW + g * 64 + r;
            F.SGU[idx] = f2bf(bf2f(F.GU[idx]) * (acc[ti][0][q] + bs)); F.SGU[idx + 32] = f2bf(bf2f(F.GU[idx + 32]) * (acc[ti][1][q] + bs)); }
    __syncthreads();
}
template <int MODE> __device__ __forceinline__ void ln_row(float* X, size_t row, const float* g, const float* bta, bf16* HBo, bf16* HLo, const bf16* Y, const int* POS, int lane) {
    float* xr = X + row * DM; f32x4 v[4];
#pragma unroll
    for (int j = 0; j < 4; ++j) v[j] = *(const f32x4*)(xr + 4 * lane + 256 * j);
    if (MODE == 1) {
        const int p0 = POS[row * TOPK], p1 = POS[row * TOPK + 1], p2 = POS[row * TOPK + 2], p3 = POS[row * TOPK + 3];
#pragma unroll
        for (int j = 0; j < 4; ++j) { v[j] = v[j] * ALPHA;
            const int pp[4] = {p0, p1, p2, p3};
#pragma unroll
            for (int k = 0; k < TOPK; ++k) { const u32x2 w = *(const u32x2*)(Y + (size_t)pp[k] * DM + 4 * lane + 256 * j);
                v[j][0] += __builtin_bit_cast(float, w.x << 16); v[j][1] += __builtin_bit_cast(float, w.x & 0xffff0000u); v[j][2] += __builtin_bit_cast(float, w.y << 16); v[j][3] += __builtin_bit_cast(float, w.y & 0xffff0000u); } }
    }
    float s = 0.f;
#pragma unroll
    for (int j = 0; j < 4; ++j) s += (v[j][0] + v[j][1]) + (v[j][2] + v[j][3]);
    const float mean = wave_sum(s) * (1.f / DM); float s2 = 0.f;
#pragma unroll
    for (int j = 0; j < 4; ++j) { v[j] = v[j] - mean; s2 += (v[j][0] * v[j][0] + v[j][1] * v[j][1]) + (v[j][2] * v[j][2] + v[j][3] * v[j][3]); }
    const float rstd = 1.f / sqrtf(wave_sum(s2) * (1.f / DM) + LN_EPS);
#pragma unroll
    for (int j = 0; j < 4; ++j) { const int c = 4 * lane + 256 * j; const f32x4 gg = *(const f32x4*)(g + c), bb = *(const f32x4*)(bta + c);
        const f32x4 o = v[j] * rstd * gg + bb; *(f32x4*)(xr + c) = o;
        if (HBo) { u32x2 w; w.x = pk2(o[0], o[1]); w.y = pk2(o[2], o[3]); *(u32x2*)(HBo + row * DM + c) = w;
            if (HLo) { u32x2 l; l.x = pk2(o[0] - __builtin_bit_cast(float, w.x << 16), o[1] - __builtin_bit_cast(float, w.x & 0xffff0000u)); l.y = pk2(o[2] - __builtin_bit_cast(float, w.y << 16), o[3] - __builtin_bit_cast(float, w.y & 0xffff0000u)); *(u32x2*)(HLo + row * DM + c) = l; } } }
}
__device__ __forceinline__ void p5_ln1_router(Frame& F) {
    LAS unsigned* LCNT = (LAS unsigned*)F.lds; LAS unsigned* LBASE = LCNT + 32;
    const int lane = F.lane; const size_t row0 = ((size_t)blockIdx.x * 8 + F.wave) * 16;
    if (F.tid < 32) LCNT[F.tid] = 0u;
    for (int rr = 0; rr < 16; ++rr) ln_row<0>(F.out, row0 + rr, F.ln1g, F.ln1b, F.HB, F.HL, nullptr, nullptr, lane);
    asm volatile("s_waitcnt vmcnt(0)" ::: "memory");
    __syncthreads();
    f32x4 acc0 = {0.f, 0.f, 0.f, 0.f}, acc1 = {0.f, 0.f, 0.f, 0.f};
    const int ar = lane & 15, kq = lane >> 4;
    const bf16* ah = F.HB + (row0 + ar) * DM + 8 * kq; const bf16* al = F.HL + (row0 + ar) * DM + 8 * kq;
    const bf16* bh0 = F.WRH + (size_t)ar * DM + 8 * kq; const bf16* bh1 = bh0 + 16 * DM; const bf16* bl0 = F.WRL + (size_t)ar * DM + 8 * kq; const bf16* bl1 = bl0 + 16 * DM;
#pragma unroll 4
    for (int ks = 0; ks < 32; ++ks) {
        const bf16x8 xh = *(const bf16x8*)(ah + 32 * ks), xl = *(const bf16x8*)(al + 32 * ks);
        const bf16x8 wh0 = *(const bf16x8*)(bh0 + 32 * ks), wh1 = *(const bf16x8*)(bh1 + 32 * ks), wl0 = *(const bf16x8*)(bl0 + 32 * ks), wl1 = *(const bf16x8*)(bl1 + 32 * ks);
        acc0 = __builtin_amdgcn_mfma_f32_16x16x32_bf16(xh, wh0, acc0, 0, 0, 0); acc1 = __builtin_amdgcn_mfma_f32_16x16x32_bf16(xh, wh1, acc1, 0, 0, 0);
        acc0 = __builtin_amdgcn_mfma_f32_16x16x32_bf16(xh, wl0, acc0, 0, 0, 0); acc1 = __builtin_amdgcn_mfma_f32_16x16x32_bf16(xh, wl1, acc1, 0, 0, 0);
        acc0 = __builtin_amdgcn_mfma_f32_16x16x32_bf16(xl, wh0, acc0, 0, 0, 0); acc1 = __builtin_amdgcn_mfma_f32_16x16x32_bf16(xl, wh1, acc1, 0, 0, 0);
    }
    const float br0 = F.b_r[ar], br1 = F.b_r[16 + ar];
    int e_sel[4]; float g_sel[4];
#pragma unroll
    for (int q = 0; q < 4; ++q) {
        float f0 = __builtin_bit_cast(float, (__builtin_bit_cast(unsigned, acc0[q] + br0) & ~31u) | (unsigned)(31 - ar));
        float f1 = __builtin_bit_cast(float, (__builtin_bit_cast(unsigned, acc1[q] + br1) & ~31u) | (unsigned)(15 - ar));
        float w[4];
#pragma unroll
        for (int it = 0; it < 4; ++it) { float m = fmaxf(f0, f1);
            m = fmaxf(m, __shfl_xor(m, 1)); m = fmaxf(m, __shfl_xor(m, 2)); m = fmaxf(m, __shfl_xor(m, 4)); m = fmaxf(m, __shfl_xor(m, 8));
            w[it] = m; if (f0 == m) f0 = -INFINITY; if (f1 == m) f1 = -INFINITY; }
        const float e1 = __expf(w[1] - w[0]), e2 = __expf(w[2] - w[0]), e3 = __expf(w[3] - w[0]), inv = 1.f / (1.f + e1 + e2 + e3);
        const float wk = ar == 0 ? w[0] : ar == 1 ? w[1] : ar == 2 ? w[2] : w[3];
        e_sel[q] = 31 - (int)(__builtin_bit_cast(unsigned, wk) & 31u);
        g_sel[q] = (ar == 0 ? 1.f : ar == 1 ? e1 : ar == 2 ? e2 : e3) * inv;
    }
    unsigned lpos[4];
    if (ar < 4) {
#pragma unroll
        for (int q = 0; q < 4; ++q) lpos[q] = __hip_atomic_fetch_add(LCNT + e_sel[q], 1u, __ATOMIC_RELAXED, __HIP_MEMORY_SCOPE_WORKGROUP);
    }
    __syncthreads();
    if (F.tid < 32) LBASE[F.tid] = atomicAdd(F.ctl + CW_CNT + F.tid, LCNT[F.tid]);
    __syncthreads();
    if (ar < 4) {
#pragma unroll
        for (int q = 0; q < 4; ++q) { const int tk = (int)(row0 + 4 * kq + q) * TOPK + ar; F.LIST[(size_t)e_sel[q] * T + LBASE[e_sel[q]] + lpos[q]] = tk; F.TOPG[tk] = g_sel[q]; }
    }
}
__device__ __forceinline__ void p6_tables(Frame& F) {
    const int gt = F.vcu * (NWAVES * 64) + F.tid, NGT = F.G * NWAVES * 64;
    for (int row = gt; row < ROWCAP; row += NGT) {
        int base = 0, e = -1, pos = 0, ce = 0;
        for (int j = 0; j < NE; ++j) { const int c = (int)__hip_atomic_load(F.ctl + CW_CNT + j, RLX_AGENT), pc = (c + 255) & ~255; if (e < 0 && row < base + pc) { e = j; pos = row - base; ce = c; } base += pc; }
        if ((row & 255) == 0) F.TILEE[row >> 8] = e;
        if (e >= 0 && pos < ce) { const int tk = F.LIST[(size_t)e * T + pos]; F.ROWTOK[row] = tk >> 2; F.ROWG[row] = F.TOPG[tk]; F.POS[tk] = row; }
        else { F.ROWTOK[row] = 0; F.ROWG[row] = 0.f; }
    }
}

__global__ void __launch_bounds__(NWAVES * 64, 2) mega(MArgs args) {
    extern __shared__ __attribute__((aligned(16))) unsigned char lds_raw[];
    Frame F;
    F.lds = (LAS unsigned char*)lds_raw;
    F.tid = threadIdx.x; F.lane = F.tid & 63; F.wave = __builtin_amdgcn_readfirstlane(F.tid >> 6);
    F.G = gridDim.x; { const int bx = blockIdx.x; F.vcu = (F.G % 8 == 0) ? (bx % 8) * (F.G / 8) + bx / 8 : bx; }
    F.x = args.in[0]; F.p = args.in[1]; F.w_in = args.in[2]; F.b_in = args.in[3]; F.gln_g = args.in[4]; F.gln_b = args.in[5]; F.w_sp = args.in[6]; F.b_sp = args.in[7];
    F.w_a = args.in[8]; F.w_b = args.in[9]; F.w_o = args.in[10]; F.b_o = args.in[11]; F.ln1g = args.in[12]; F.ln1b = args.in[13]; F.w_r = args.in[14]; F.b_r = args.in[15];
    F.w_gu = args.in[16]; F.b_gu = args.in[17]; F.w_dn = args.in[18]; F.b_dn = args.in[19]; F.ln2g = args.in[20]; F.ln2b = args.in[21]; F.w_ple = args.in[22]; F.w_pg = args.in[23];
    F.b_pg = args.in[24]; F.ln3g = args.in[25]; F.ln3b = args.in[26]; F.out = args.out;
    unsigned char* ws = args.ws; F.ctl = (unsigned*)(ws + WS_CTL);
    F.WIN = (bf16*)(ws + WS_WIN); F.WA = (bf16*)(ws + WS_WA); F.WB = (bf16*)(ws + WS_WB); F.WO = (bf16*)(ws + WS_WO); F.WPG = (bf16*)(ws + WS_WPG); F.WPLE = (bf16*)(ws + WS_WPLE);
    F.WSP = (bf16*)(ws + WS_WSP); F.WRH = (bf16*)(ws + WS_WRH); F.WRL = (bf16*)(ws + WS_WRL); F.WGU = (bf16*)(ws + WS_WGU); F.WDN = (bf16*)(ws + WS_WDN); F.HB = (bf16*)(ws + WS_HB); F.PB = (bf16*)(ws + WS_PB);
    F.FLOG = (float*)(ws + WS_FLOG); F.CN = (float*)(ws + WS_CN); F.TOPG = (float*)(ws + WS_TOPG); F.ROWG = (float*)(ws + WS_ROWG);
    F.POS = (int*)(ws + WS_POS); F.LIST = (int*)(ws + WS_LIST); F.ROWTOK = (int*)(ws + WS_ROWTOK); F.TILEE = (int*)(ws + WS_TILEE);
    unsigned char* A = ws + WS_A;
    F.XB = (bf16*)(A + A_XB); F.Q = (bf16*)(A + A_Q); F.K = (bf16*)(A + A_K); F.V = (bf16*)(A + A_V); F.GU = (bf16*)(A + A_GU); F.GV = (bf16*)(A + A_GV); F.GA = (bf16*)(A + A_GA); F.GB = (bf16*)(A + A_GB);
    F.ATT = (bf16*)(A + A_ATT); F.SGU = (bf16*)(A + A_SGU); F.MRG = (bf16*)(A + A_MRG); F.HID = (bf16*)(A + A_HID); F.Y = (bf16*)(A + A_Y); F.HL = (bf16*)(A + A_HL); F.TMPF = (float*)(A + A_TMPF);
    bf16* Gbuf = (bf16*)(A + A_G);
    for (int u = F.tid; u < (LDS_BYTES - LDSCTL_OFF) / 4; u += NWAVES * 64) ((LAS unsigned*)(F.lds + LDSCTL_OFF))[u] = 0u;
    __syncthreads();
    volatile LAS unsigned* MISC = (volatile LAS unsigned*)(F.lds + MISC_OFF);
    const int lo = args.ph_lo, hi = args.ph_hi;
    XcdBarrier bar; bar.bar = F.ctl + CW_BAR + args.li * XCD_BAR_WORDS; bar.x = 0; bar.st = nullptr;
    if (hi - lo > 1) bar = xcd_barrier_post(F.ctl + CW_BAR + args.li * XCD_BAR_WORDS, MISC + 8);
#define IN(k) (lo <= (k) && (k) < hi)
#define SEAM(k) do { if (IN(k) && IN((k) + 1)) xcd_barrier(bar); } while (0)
    const int gw = F.vcu * NWAVES + F.wave, NGW = F.G * NWAVES;

    if (IN(0)) { p0_prologue(F); } SEAM(0);
    if (IN(1)) {
        p1_cumsum(F);
        pg8::DenseOrder S; S.init(F.XB, F.WIN, T, DINC, DM, F.G, (int)blockIdx.x);
        pg8::EpInproj E{F.b_in, F.Q, F.K, F.V, F.GU, F.GV, F.GA, F.GB};
        pg8::gemm_phase<pg8::EpInproj, pg8::DenseOrder, true>(F.lds, DM, S, E);
    } SEAM(1);
    if (IN(2)) {
        sgu_unit(F, F.vcu >> 4, F.vcu & 15);
        const attn_body::AttnTensors AT{(const attn_body::bf16*)F.Q, (const attn_body::bf16*)F.K, (const attn_body::bf16*)F.V, (attn_body::bf16*)F.ATT, F.CN};
        const attn_body::StaticOrder S((int)F.G, (int)blockIdx.x);
        attn_body::attn_phase<attn_body::StaticOrder>((char*)lds_raw, AT, S);
    } SEAM(2);
    if (IN(3)) {
        { pg8::DenseOrder S; S.init(F.ATT, F.WA, T, DM, FW, F.G, (int)blockIdx.x); pg8::EpBrA E{F.GA, F.TMPF}; pg8::gemm_phase<pg8::EpBrA, pg8::DenseOrder, true>(F.lds, FW, S, E); }
        { pg8::DenseOrder S; S.init(F.SGU, F.WB, T, DM, GW, F.G, (int)blockIdx.x); pg8::EpBrB E{F.GB, F.TMPF, F.MRG}; pg8::gemm_phase<pg8::EpBrB, pg8::DenseOrder, true>(F.lds, GW, S, E); }
    } SEAM(3);
    if (IN(4)) {
        pg8::DenseOrder S; S.init(F.MRG, F.WO, T, DM, DM, F.G, (int)blockIdx.x); pg8::EpOut E{F.x, F.b_o, F.out}; pg8::gemm_phase<pg8::EpOut, pg8::DenseOrder, true>(F.lds, DM, S, E);
    } SEAM(4);
    if (IN(5)) { p5_ln1_router(F); } SEAM(5);
    if (IN(6)) { p6_tables(F); } SEAM(6);
    if (IN(7)) {
        pg8::MoeOrder S{F.TILEE, F.ROWTOK, (const char*)F.HB, (const char*)F.WGU, (size_t)2 * DFF * DM * 2, DM, 8, (int)blockIdx.x}; pg8::EpGU E{F.b_gu, F.HID};
        pg8::gemm_phase<pg8::EpGU, pg8::MoeOrder, true>(F.lds, DM, S, E);
    } SEAM(7);
    if (IN(8)) {
        pg8::MoeOrder S{F.TILEE, nullptr, (const char*)F.HID, (const char*)F.WDN, (size_t)DM * DFF * 2, DFF, 4, (int)blockIdx.x}; pg8::EpDn E{F.b_dn, F.ROWG, F.Y};
        pg8::gemm_phase<pg8::EpDn, pg8::MoeOrder, true>(F.lds, DFF, S, E);
    } SEAM(8);
    if (IN(9)) { for (int row = gw; row < T; row += NGW) ln_row<1>(F.out, (size_t)row, F.ln2g, F.ln2b, F.HB, nullptr, F.Y, F.POS, F.lane); } SEAM(9);
    if (IN(10)) {
        pg8::DenseOrder S; S.init(F.HB, F.WPG, T, DM, DM, F.G, (int)blockIdx.x); pg8::EpPG E{F.b_pg, Gbuf}; pg8::gemm_phase<pg8::EpPG, pg8::DenseOrder, true>(F.lds, DM, S, E);
    } SEAM(10);
    if (IN(11)) {
        pg8::DenseOrder S; S.init(F.PB, F.WPLE, T, DM, PLE, F.G, (int)blockIdx.x); pg8::EpPle E{Gbuf, F.out}; pg8::gemm_phase<pg8::EpPle, pg8::DenseOrder, true>(F.lds, PLE, S, E);
    } SEAM(11);
    if (IN(12)) { for (int row = gw; row < T; row += NGW) ln_row<0>(F.out, (size_t)row, F.ln3g, F.ln3b, nullptr, nullptr, nullptr, nullptr, F.lane); }
#undef IN
#undef SEAM
}

#ifndef FASTMASK
#define FASTMASK 0x1fff
#endif
__global__ void __launch_bounds__(256) k_conv_wr(const float* w_r, bf16* WRH, bf16* WRL) {
    const int i = blockIdx.x * 256 + threadIdx.x; const int e = i >> 10, k = i & 1023; const float w = w_r[(size_t)k * NE + e]; const bf16 hi = f2bf(w); WRH[i] = hi; WRL[i] = f2bf(w - bf2f(hi));
}
extern "C" void kernel_launch(void* const* d_in, const int* in_sizes, int n_in, void* d_out, int out_size, void* d_ws, size_t ws_size, hipStream_t stream) {
    if (n_in != 27 || out_size != T * DM || ws_size < WS_END) { fprintf(stderr, "kernel_launch: unexpected shapes (n_in %d out %d ws %zu)\n", n_in, out_size, ws_size); return; }
    static int grid = 0;
    if (grid == 0) {
        int dev = 0, cus = 0, per_cu = 0;
        if (hipGetDevice(&dev) != hipSuccess || hipDeviceGetAttribute(&cus, hipDeviceAttributeMultiprocessorCount, dev) != hipSuccess) { fprintf(stderr, "kernel_launch: device query failed\n"); grid = -1; return; }
        if (hipFuncSetAttribute((const void*)mega, hipFuncAttributeMaxDynamicSharedMemorySize, LDS_BYTES) != hipSuccess) { fprintf(stderr, "kernel_launch: hipFuncSetAttribute failed\n"); grid = -1; return; }
        if (hipOccupancyMaxActiveBlocksPerMultiprocessor(&per_cu, (const void*)mega, NWAVES * 64, LDS_BYTES) != hipSuccess || per_cu < 1) { fprintf(stderr, "kernel_launch: occupancy query says %d workgroups per CU\n", per_cu); per_cu = 1; }
        (void)hipGetLastError();
        grid = cus;
        if (grid != 256) fprintf(stderr, "kernel_launch: %d CUs (built for 256)\n", grid);
    }
    if (grid < 0) return;
    const float* x = (const float*)d_in[0]; const float* p = (const float*)d_in[1]; const float* w_in = (const float*)d_in[2]; const float* b_in = (const float*)d_in[3];
    const float* gln_g = (const float*)d_in[4]; const float* gln_b = (const float*)d_in[5]; const float* w_sp = (const float*)d_in[6]; const float* b_sp = (const float*)d_in[7];
    const float* w_a = (const float*)d_in[8]; const float* w_b = (const float*)d_in[9]; const float* w_o = (const float*)d_in[10]; const float* b_o = (const float*)d_in[11];
    const float* ln1g = (const float*)d_in[12]; const float* ln1b = (const float*)d_in[13]; const float* w_r = (const float*)d_in[14]; const float* b_r = (const float*)d_in[15];
    const float* w_gu = (const float*)d_in[16]; const float* b_gu = (const float*)d_in[17]; const float* w_dn = (const float*)d_in[18]; const float* b_dn = (const float*)d_in[19];
    const float* ln2g = (const float*)d_in[20]; const float* ln2b = (const float*)d_in[21]; const float* w_ple = (const float*)d_in[22]; const float* w_pg = (const float*)d_in[23];
    const float* b_pg = (const float*)d_in[24]; const float* ln3g = (const float*)d_in[25]; const float* ln3b = (const float*)d_in[26];
    unsigned char* ws = (unsigned char*)d_ws; float* out = (float*)d_out;
    bf16 *WIN = (bf16*)(ws + WS_WIN), *WA = (bf16*)(ws + WS_WA), *WB = (bf16*)(ws + WS_WB), *WO = (bf16*)(ws + WS_WO), *WPG = (bf16*)(ws + WS_WPG), *WPLE = (bf16*)(ws + WS_WPLE), *WSP = (bf16*)(ws + WS_WSP);
    bf16 *WRH = (bf16*)(ws + WS_WRH), *WRL = (bf16*)(ws + WS_WRL);
    bf16 *WGU = (bf16*)(ws + WS_WGU), *WDN = (bf16*)(ws + WS_WDN), *HB = (bf16*)(ws + WS_HB), *PB = (bf16*)(ws + WS_PB);
    float *FLOG = (float*)(ws + WS_FLOG), *CN = (float*)(ws + WS_CN), *TOPG = (float*)(ws + WS_TOPG), *ROWG = (float*)(ws + WS_ROWG);
    int *POS = (int*)(ws + WS_POS), *LIST = (int*)(ws + WS_LIST), *ROWTOK = (int*)(ws + WS_ROWTOK), *TILEE = (int*)(ws + WS_TILEE);
    unsigned* ctl = (unsigned*)(ws + WS_CTL);
    unsigned char* A = ws + WS_A;
    bf16 *XB = (bf16*)(A + A_XB), *Q = (bf16*)(A + A_Q), *K = (bf16*)(A + A_K), *V = (bf16*)(A + A_V), *GU = (bf16*)(A + A_GU), *GV = (bf16*)(A + A_GV), *GA = (bf16*)(A + A_GA), *GB = (bf16*)(A + A_GB);
    bf16 *ATT = (bf16*)(A + A_ATT), *SGU = (bf16*)(A + A_SGU), *MRG = (bf16*)(A + A_MRG), *HID = (bf16*)(A + A_HID), *Y = (bf16*)(A + A_Y), *G = (bf16*)(A + A_G);
    float* TMPF = (float*)(A + A_TMPF);

    (void)hipMemsetAsync(ws + WS_CTL, 0, CTL_BYTES, stream);
    MArgs ma; for (int i = 0; i < 27; ++i) ma.in[i] = (const float*)d_in[i]; ma.out = out; ma.ws = ws; ma.ph_lo = 0; ma.ph_hi = 0; ma.li = 0; ma.pad = 0;
    int li = 0;
    for (int ph = 0; ph < 13;) {
        if ((FASTMASK >> ph) & 1) { int hi = ph; while (hi < 13 && ((FASTMASK >> hi) & 1)) ++hi;
            ma.ph_lo = ph; ma.ph_hi = hi; ma.li = li++; hipLaunchKernelGGL(mega, dim3(grid), dim3(NWAVES * 64), LDS_BYTES, stream, ma); ph = hi; continue; }
        switch (ph) {
        case 0:
            k_convT<1><<<dim3(DINC / 32, DM / 32, 1), 256, 0, stream>>>(w_in, WIN, DM, DIN, 0, 0);
            k_convT<0><<<dim3(DM / 32, FW / 32, 1), 256, 0, stream>>>(w_a, WA, FW, DM, 0, 0);
            k_convT<0><<<dim3(DM / 32, GW / 32, 1), 256, 0, stream>>>(w_b, WB, GW, DM, 0, 0);
            k_convT<0><<<dim3(DM / 32, DM / 32, 1), 256, 0, stream>>>(w_o, WO, DM, DM, 0, 0);
            k_convT<0><<<dim3(DM / 32, DM / 32, 1), 256, 0, stream>>>(w_pg, WPG, DM, DM, 0, 0);
            k_convT<0><<<dim3(DM / 32, PLE / 32, 1), 256, 0, stream>>>(w_ple, WPLE, PLE, DM, 0, 0);
            k_convT<2><<<dim3(2 * DFF / 32, DM / 32, NE), 256, 0, stream>>>(w_gu, WGU, DM, 2 * DFF, (size_t)DM * 2 * DFF, (size_t)DM * 2 * DFF);
            k_convT<0><<<dim3(DM / 32, DFF / 32, NE), 256, 0, stream>>>(w_dn, WDN, DFF, DM, (size_t)DFF * DM, (size_t)DFF * DM);
            k_conv_wsp<<<NGRP * 128 * 128 / 256, 256, 0, stream>>>(w_sp, WSP);
            k_conv_wr<<<NE * DM / 256, 256, 0, stream>>>(w_r, WRH, WRL);
            k_conv_p<<<T * PLE / 1024, 256, 0, stream>>>(p, PB);
            k_prep_x<<<T / 4, 256, 0, stream>>>(x, w_in, b_in, XB, FLOG);
            break;
        case 1: { k_cumsum<<<NB * NH, 256, 0, stream>>>(FLOG, CN);
            NG g = mkng(XB, DM, nullptr, WIN, DM, DM, nullptr, 0); EpInproj ep{b_in, Q, K, V, GU, GV, GA, GB}; k_ngemm<EpInproj, false><<<dim3(DINC / 128, T / 128), 256, 0, stream>>>(g, ep); } break;
        case 2:
            k_attn_naive<<<NB * NH * SEQ / 4, 256, 0, stream>>>(Q, K, V, CN, ATT);
            k_sgu_naive<<<NB * 16 * NGRP, 256, 0, stream>>>(GV, GU, gln_g, gln_b, WSP, b_sp, SGU);
            break;
        case 3: { { NG g = mkng(ATT, FW, nullptr, WA, FW, FW, nullptr, 0); EpBrA ep{GA, TMPF}; k_ngemm<EpBrA, false><<<dim3(DM / 128, T / 128), 256, 0, stream>>>(g, ep); }
            { NG g = mkng(SGU, GW, nullptr, WB, GW, GW, nullptr, 0); EpBrB ep{GB, TMPF, MRG}; k_ngemm<EpBrB, false><<<dim3(DM / 128, T / 128), 256, 0, stream>>>(g, ep); } } break;
        case 4: { NG g = mkng(MRG, DM, nullptr, WO, DM, DM, nullptr, 0); EpOut ep{x, b_o, out}; k_ngemm<EpOut, false><<<dim3(DM / 128, T / 128), 256, 0, stream>>>(g, ep); } break;
        case 5:
            k_ln_rows<0><<<T / 4, 256, 0, stream>>>(out, ln1g, ln1b, HB, nullptr, nullptr);
            k_router_naive<<<T / 4, 256, 0, stream>>>(out, w_r, b_r, TOPG, ctl + CW_CNT, LIST);
            break;
        case 6: k_scatter_naive<<<NTILE256, 256, 0, stream>>>(ctl + CW_CNT, LIST, TOPG, ROWTOK, ROWG, POS, TILEE); break;
        case 7: { NG g = mkng(HB, DM, ROWTOK, WGU, DM, DM, TILEE, (size_t)2 * DFF * DM); EpGU ep{b_gu, HID}; k_ngemm<EpGU, true><<<dim3(DFF / 128, ROWCAP / 128), 256, 0, stream>>>(g, ep); } break;
        case 8: { NG g = mkng(HID, DFF, nullptr, WDN, DFF, DFF, TILEE, (size_t)DM * DFF); EpDn ep{b_dn, ROWG, Y}; k_ngemm<EpDn, false><<<dim3(DM / 128, ROWCAP / 128), 256, 0, stream>>>(g, ep); } break;
        case 9: k_ln_rows<1><<<T / 4, 256, 0, stream>>>(out, ln2g, ln2b, HB, Y, POS); break;
        case 10: { NG g = mkng(HB, DM, nullptr, WPG, DM, DM, nullptr, 0); EpPG ep{b_pg, G}; k_ngemm<EpPG, false><<<dim3(DM / 128, T / 128), 256, 0, stream>>>(g, ep); } break;
        case 11: { NG g = mkng(PB, PLE, nullptr, WPLE, PLE, PLE, nullptr, 0); EpPle ep{G, out}; k_ngemm<EpPle, false><<<dim3(DM / 128, T / 128), 256, 0, stream>>>(g, ep); } break;
        case 12: k_ln_rows<0><<<T / 4, 256, 0, stream>>>(out, ln3g, ln3b, nullptr, nullptr, nullptr); break;
        }
        ++ph;
    }
}
```

```cpp
#include <hip/hip_runtime.h>
#include <cstdio>
#include <cstdint>

typedef unsigned short bf16;
typedef short bf16x8 __attribute__((ext_vector_type(8)));
typedef float f32x4 __attribute__((ext_vector_type(4)));
typedef float f32x16 __attribute__((ext_vector_type(16)));
typedef unsigned u32x2 __attribute__((ext_vector_type(2)));
typedef unsigned u32x4 __attribute__((ext_vector_type(4)));

constexpr int NB = 16, SEQ = 2048, T = NB * SEQ, DM = 1024, NH = 8, HD = 64, FW = 512, GW = 512, CHUNK = 128, NGRP = 8;
constexpr int NE = 32, TOPK = 4, DFF = 1024, PLE = 256;
constexpr int OFF_F = 1536, DIN = 4616, DINC = 4608;
constexpr float LN_EPS = 1e-5f, ALPHA = 1.189207115002721f, LOG2E = 1.4426950408889634f;
constexpr float QSCALE = 0.125f * LOG2E;
constexpr int ROWCAP = 139264;
constexpr int NTILE256 = ROWCAP / 256;

constexpr size_t MiB = 1u << 20;
constexpr size_t WS_CTL = 0, CTL_BYTES = 1 * MiB;
constexpr size_t WS_WIN = 1 * MiB, WS_WA = 10 * MiB, WS_WB = 11 * MiB, WS_WO = 12 * MiB, WS_WPG = 14 * MiB, WS_WPLE = 16 * MiB, WS_WSP = 17 * MiB, WS_WRH = 17 * MiB + 512 * 1024, WS_WRL = 17 * MiB + 768 * 1024;
constexpr size_t WS_FLOG = 18 * MiB, WS_CN = 19 * MiB, WS_TOPG = 20 * MiB, WS_POS = 20 * MiB + 512 * 1024, WS_LIST = 21 * MiB, WS_ROWTOK = 25 * MiB, WS_ROWG = 26 * MiB, WS_TILEE = 27 * MiB;
constexpr size_t WS_PB = 28 * MiB, WS_WGU = 44 * MiB, WS_WDN = 172 * MiB, WS_HB = 236 * MiB, WS_A = 300 * MiB, WS_END = 844 * MiB;
constexpr size_t A_XB = 0, A_Q = 64 * MiB, A_K = 96 * MiB, A_V = 128 * MiB, A_GU = 160 * MiB, A_GV = 192 * MiB, A_GA = 224 * MiB, A_GB = 288 * MiB, A_ATT = 352 * MiB, A_SGU = 384 * MiB, A_MRG = 416 * MiB;
constexpr size_t A_TMPF = 0;
constexpr size_t A_HID = 0, A_Y = 272 * MiB;
constexpr size_t A_G = 0;
constexpr size_t A_HL = 0;
constexpr int CW_CNT = 64;

__device__ __forceinline__ bf16 f2bf(float f) { unsigned u = __builtin_bit_cast(unsigned, f); return (bf16)((u + 0x7fffu + ((u >> 16) & 1u)) >> 16); }
__device__ __forceinline__ float bf2f(bf16 h) { return __builtin_bit_cast(float, (unsigned)h << 16); }
__device__ __forceinline__ unsigned pk2(float lo, float hi) { return (unsigned)f2bf(lo) | ((unsigned)f2bf(hi) << 16); }
__device__ __forceinline__ float sigmoidf_(float v) { return 1.f / (1.f + __expf(-v)); }
__device__ __forceinline__ float gelu_tanh(float v) { const float u = 0.7978845608028654f * (v + 0.044715f * v * v * v); return v / (1.f + __expf(-2.f * u)); }
__device__ __forceinline__ float wave_sum(float v) {
#pragma unroll
    for (int o = 1; o < 64; o <<= 1) v += __shfl_xor(v, o);
    return v;
}
__device__ __forceinline__ float wave_max(float v) {
#pragma unroll
    for (int o = 1; o < 64; o <<= 1) v = fmaxf(v, __shfl_xor(v, o));
    return v;
}

template <int MODE> __device__ __forceinline__ int colmap(int n) {
    if (MODE == 1) return n < OFF_F ? n : n + 8;
    if (MODE == 2) { const int tile = n >> 8, half = (n >> 7) & 1, c = n & 127; return half * DFF + tile * 128 + c; }
    return n;
}
#define LAS __attribute__((address_space(3)))
#define GAS __attribute__((address_space(1)))
typedef GAS unsigned gu32;
#define RLX_AGENT __ATOMIC_RELAXED, __HIP_MEMORY_SCOPE_AGENT
constexpr int NWAVES = 8;
constexpr int RING_BYTES = 131072, LDSCTL_OFF = RING_BYTES, MISC_OFF = LDSCTL_OFF + 320, LDS_BYTES = 147456;

namespace pg8 {
#define PG8_LAS __attribute__((address_space(3)))
constexpr int BM = 256, BK = 64, HALF = 128, HTB = HALF * BK * 2, STAGE_BYTES = 8 * HTB, NXCD = 8, WGM = 8;
__host__ __device__ __forceinline__ int lds_byte(int r, int c) { const int st = (r >> 4) * 2 + (c >> 5), rr = r & 15, cc = c & 31, ob = rr * 64 + cc * 2; return st * 1024 + (ob ^ (((ob >> 9) & 1) << 5)); }
__host__ __device__ __forceinline__ void stage_rc(int b, int& R, int& C) { const int st = b / 1024, sb = b % 1024, swz = sb ^ (((sb >> 9) & 1) << 5); R = (st >> 1) * 16 + swz / 64; C = (st & 1) * 32 + (swz % 64) / 2; }
__host__ __device__ __forceinline__ int perm32(int rho) { const int n = rho >> 4, i = rho & 15; return 8 * (i >> 2) + 4 * n + (i & 3); }

struct Unit { int pm, pn, e, pos0, cnt; const char* A; const char* B; };

struct DenseOrder {
    int nM, nN, nwg, G, c, K; const char* A; const char* Bt;
    __device__ void init(const void* A_, const void* Bt_, int M, int N, int K_, int G_, int c_) { nM = M / BM; nN = N / BM; nwg = nM * nN; G = G_; c = c_; K = K_; A = (const char*)A_; Bt = (const char*)Bt_; }
    __device__ __forceinline__ bool next(int i, Unit& u) const {
        const long L = (long)i * G + c; if (L >= nwg) return false;
        int wgid = (int)L; { const int q = nwg / NXCD, r = nwg % NXCD, xcd = wgid % NXCD, off = wgid / NXCD; wgid = (xcd < r ? xcd * (q + 1) : r * (q + 1) + (xcd - r) * q) + off; }
        const int nig = WGM * nN, gid = wgid / nig, fm = gid * WGM, gsz = (nM - fm) < WGM ? (nM - fm) : WGM;
        u.pm = fm + ((wgid % nig) % gsz); u.pn = (wgid % nig) / gsz; u.e = 0; u.pos0 = 0; u.cnt = 0;
        u.A = A + (size_t)u.pm * BM * K * 2; u.B = Bt + (size_t)u.pn * BM * K * 2; return true;
    }
    __device__ __forceinline__ void a_off(const Unit&, int tid, unsigned (&off)[2][2]) const {
#pragma unroll
        for (int i = 0; i < 2; ++i) { int R, C; stage_rc(tid * 16 + i * 8192, R, C); off[0][i] = (unsigned)(R * K + C) * 2u; off[1][i] = off[0][i] + (unsigned)(HALF * K * 2); }
    }
};
struct MoeOrder {
    const PG8_LAS int* tb; const PG8_LAS int* cntl; const int* list; const char* A; const char* Bt; size_t estride; int K, NCT, c; bool gather;
    __device__ __forceinline__ bool next(int i, Unit& u) const {
        const int xcd = c & 7, j = c >> 3, rpx = 32 / NCT, tile = i * (256 / NCT) + xcd * rpx + j / NCT;
        if (tile >= tb[32]) return false;
        const int l = (int)threadIdx.x & 31; const bool hit = tb[l] <= tile && tile < tb[l + 1];
        const int e = __builtin_amdgcn_readfirstlane(__ffsll((unsigned long long)__ballot(hit)) - 1);
        u.pm = tile; u.pn = j % NCT; u.e = e; u.pos0 = __builtin_amdgcn_readfirstlane((tile - tb[e]) * BM); u.cnt = __builtin_amdgcn_readfirstlane(cntl[e]);
        u.A = gather ? A : A + (size_t)tile * BM * K * 2; u.B = Bt + (size_t)e * estride + (size_t)u.pn * BM * K * 2; return true;
    }
    __device__ __forceinline__ void a_off(const Unit& u, int tid, unsigned (&off)[2][2]) const {
#pragma unroll
        for (int i = 0; i < 2; ++i) { int R, C; stage_rc(tid * 16 + i * 8192, R, C);
            if (gather) { const int p0 = u.pos0 + R, p1 = p0 + HALF; const int* le = list + (size_t)u.e * T;
                const int t0 = p0 < u.cnt ? (le[p0] >> 2) : 0, t1 = p1 < u.cnt ? (le[p1] >> 2) : 0;
                off[0][i] = (unsigned)(t0 * K + C) * 2u; off[1][i] = (unsigned)(t1 * K + C) * 2u; }
            else { off[0][i] = (unsigned)(R * K + C) * 2u; off[1][i] = off[0][i] + (unsigned)(HALF * K * 2); } }
    }
};

template <class Epi, class Sched, bool ALIGN_EPI>
__device__ __forceinline__ void gemm_phase(PG8_LAS unsigned char* lds, const int K, const Sched& S, const Epi& E) {
    int tid_ = threadIdx.x; asm volatile("" : "+v"(tid_));
    const int tid = tid_, wid = __builtin_amdgcn_readfirstlane(tid >> 6), lane = tid & 63, wr = wid >> 2, wc = wid & 3, fr = lane & 15, fq = lane >> 4;
    const int nt = K / BK;
    unsigned voffB[2];
#pragma unroll
    for (int i = 0; i < 2; ++i) { int R, C; stage_rc(tid * 16 + i * 8192, R, C); const int Rb = Epi::PERM ? ((R & ~31) + perm32(R & 31)) : R; voffB[i] = (unsigned)(Rb * K + C) * 2u; }
    const size_t kstep = (size_t)(BK * 2);
    const size_t hstep = (size_t)HALF * K * 2;
    const unsigned ldsw = (unsigned)wid * 1024u;
    const int aoff = lds_byte(wr * 64 + fr, fq * 8), boff = lds_byte(wc * 32 + fr, fq * 8);
#define PG8_SA(b, h) (((b) * 2 + (h)) * HTB)
#define PG8_SB(b, h) ((4 + (b) * 2 + (h)) * HTB)
#define PG8_STAGE(bufoff, gbase, voff) do { _Pragma("unroll") for (int _i = 0; _i < 2; ++_i) \
        __builtin_amdgcn_global_load_lds((const unsigned*)((const char*)(gbase) + (voff)[_i]), (PG8_LAS unsigned*)(lds + (bufoff) + ldsw + _i * 8192), 16, 0, 0); } while (0)
#define PG8_LDA(dst, b, h) do { _Pragma("unroll") for (int m = 0; m < 4; ++m) _Pragma("unroll") for (int k = 0; k < 2; ++k) dst[m][k] = *(const PG8_LAS bf16x8*)(lds + PG8_SA(b, h) + aoff + m * 2048 + k * 1024); } while (0)
#define PG8_LDB(dst, b, h) do { _Pragma("unroll") for (int n = 0; n < 2; ++n) _Pragma("unroll") for (int k = 0; k < 2; ++k) dst[n][k] = *(const PG8_LAS bf16x8*)(lds + PG8_SB(b, h) + boff + n * 2048 + k * 1024); } while (0)
#define PG8_MMA(ai, bj, At, Bt) do { __builtin_amdgcn_s_setprio(1); _Pragma("unroll") for (int m = 0; m < 4; ++m) _Pragma("unroll") for (int n = 0; n < 2; ++n) _Pragma("unroll") for (int k = 0; k < 2; ++k) \
        acc[ai][bj][m][n] = __builtin_amdgcn_mfma_f32_16x16x32_bf16(Bt[n][k], At[m][k], acc[ai][bj][m][n], 0, 0, 0); __builtin_amdgcn_s_setprio(0); } while (0)
#define PG8_WAIT_V(n) asm volatile("s_waitcnt vmcnt(" #n ")" ::: "memory")
#define PG8_WAIT_L(n) asm volatile("s_waitcnt lgkmcnt(" #n ")" ::: "memory")
#define PG8_BAR __builtin_amdgcn_s_barrier()
#define PG8_SCHED __builtin_amdgcn_sched_barrier(0)
    Unit cur, nxt; int ui = 0;
    if (!S.next(0, cur)) return;
    f32x4 acc[2][2][4][2];
#pragma unroll
    for (int a = 0; a < 2; ++a)
#pragma unroll
        for (int b = 0; b < 2; ++b)
#pragma unroll
            for (int m = 0; m < 4; ++m)
#pragma unroll
                for (int n = 0; n < 2; ++n) acc[a][b][m][n] = (f32x4){0.f, 0.f, 0.f, 0.f};
    bf16x8 At[4][2], B0[2][2], B1[2][2];
    unsigned cof[2][2], nof[2][2];
    S.a_off(cur, tid, cof);
    const char* cA = cur.A; const char* cB = cur.B;
    PG8_STAGE(PG8_SB(0, 0), cB, voffB); PG8_STAGE(PG8_SB(0, 1), cB + hstep, voffB); PG8_STAGE(PG8_SA(0, 0), cA, cof[0]); PG8_STAGE(PG8_SA(0, 1), cA, cof[1]);
    if (wr == 1) PG8_BAR;
    PG8_WAIT_V(2); PG8_BAR;
    PG8_STAGE(PG8_SB(1, 0), cB + kstep, voffB); PG8_STAGE(PG8_SA(1, 0), cA + kstep, cof[0]); PG8_STAGE(PG8_SB(1, 1), cB + hstep + kstep, voffB);
    PG8_WAIT_V(6); PG8_BAR;
    for (;;) {
        const bool has_next = S.next(ui + 1, nxt);
        const char* nA = has_next ? nxt.A : cA; const char* nB = has_next ? nxt.B : cB;
        if (has_next) S.a_off(nxt, tid, nof); else { nof[0][0] = cof[0][0]; nof[0][1] = cof[0][1]; nof[1][0] = cof[1][0]; nof[1][1] = cof[1][1]; }
        for (int t = 0; t < nt; t += 2) {
            const bool last = (t == nt - 2);
            const char* a1 = cA + (size_t)(t + 1) * kstep;
            const char* a2 = last ? nA : cA + (size_t)(t + 2) * kstep; const char* b2 = last ? nB : cB + (size_t)(t + 2) * kstep;
            const char* a3 = a2 + kstep; const char* b3 = b2 + kstep;
            unsigned s0[2], s1[2]; s0[0] = last ? nof[0][0] : cof[0][0]; s0[1] = last ? nof[0][1] : cof[0][1]; s1[0] = last ? nof[1][0] : cof[1][0]; s1[1] = last ? nof[1][1] : cof[1][1];
            PG8_LDB(B0, 0, 0); PG8_LDB(B1, 0, 1); PG8_SCHED; PG8_LDA(At, 0, 0); PG8_STAGE(PG8_SA(1, 1), a1, cof[1]);
            PG8_WAIT_V(8); PG8_WAIT_L(0); PG8_BAR; PG8_MMA(0, 0, At, B0); PG8_MMA(0, 1, At, B1); PG8_BAR; PG8_SCHED;
            PG8_LDA(At, 0, 1); PG8_STAGE(PG8_SB(0, 0), b2, voffB); PG8_STAGE(PG8_SB(0, 1), b2 + hstep, voffB); PG8_STAGE(PG8_SA(0, 0), a2, s0);
            PG8_WAIT_V(8); PG8_WAIT_L(0); PG8_BAR; PG8_MMA(1, 0, At, B0); PG8_MMA(1, 1, At, B1); PG8_BAR; PG8_SCHED;
            PG8_LDB(B0, 1, 0); PG8_LDB(B1, 1, 1); PG8_SCHED; PG8_LDA(At, 1, 0); PG8_STAGE(PG8_SA(0, 1), a2, s1);
            PG8_WAIT_V(8); PG8_WAIT_L(0); PG8_BAR; PG8_MMA(0, 0, At, B0); PG8_MMA(0, 1, At, B1); PG8_BAR; PG8_SCHED;
            PG8_LDA(At, 1, 1); PG8_STAGE(PG8_SB(1, 0), b3, voffB); PG8_STAGE(PG8_SB(1, 1), b3 + hstep, voffB); PG8_STAGE(PG8_SA(1, 0), a3, s0);
            PG8_WAIT_V(8); PG8_WAIT_L(0); PG8_BAR; PG8_MMA(1, 0, At, B0); PG8_MMA(1, 1, At, B1); PG8_BAR; PG8_SCHED;
        }
        if constexpr (ALIGN_EPI) { if (wr == 0) PG8_BAR; }
        E(acc, cur, wr, wc, fr, fq);
        if (!has_next) break;
#pragma unroll
        for (int a = 0; a < 2; ++a)
#pragma unroll
            for (int b = 0; b < 2; ++b)
#pragma unroll
                for (int m = 0; m < 4; ++m)
#pragma unroll
                    for (int n = 0; n < 2; ++n) acc[a][b][m][n] = (f32x4){0.f, 0.f, 0.f, 0.f};
        cur = nxt; cA = nA; cB = nB; ++ui;
        cof[0][0] = nof[0][0]; cof[0][1] = nof[0][1]; cof[1][0] = nof[1][0]; cof[1][1] = nof[1][1];
        if constexpr (ALIGN_EPI) { if (wr == 1) PG8_BAR; }
    }
    PG8_WAIT_V(0);
    if constexpr (!ALIGN_EPI) { if (wr == 0) PG8_BAR; }
    PG8_BAR;
#undef PG8_SA
#undef PG8_SB
#undef PG8_STAGE
#undef PG8_LDA
#undef PG8_LDB
#undef PG8_MMA
#undef PG8_WAIT_V
#undef PG8_WAIT_L
#undef PG8_BAR
#undef PG8_SCHED
}

__device__ __forceinline__ unsigned cvt_pk_bf16(float lo, float hi) { unsigned r; asm volatile("v_cvt_pk_bf16_f32 %0, %1, %2" : "=v"(r) : "v"(lo), "v"(hi)); return r; }
__device__ __forceinline__ u32x4 pack8(const f32x4 v0, const f32x4 v1) { u32x4 w; w.x = cvt_pk_bf16(v0[0], v0[1]); w.y = cvt_pk_bf16(v0[2], v0[3]); w.z = cvt_pk_bf16(v1[0], v1[1]); w.w = cvt_pk_bf16(v1[2], v1[3]); return w; }
__device__ __forceinline__ float fsigmoid(float v) { return __builtin_amdgcn_rcpf(1.f + __builtin_amdgcn_exp2f(-LOG2E * v)); }
__device__ __forceinline__ float fgelu(float v) { const float z = v * (-2.3022082f - 0.10294324f * v * v); return v * __builtin_amdgcn_rcpf(1.f + __builtin_amdgcn_exp2f(z)); }
__device__ __forceinline__ void unpack8(const u32x4 w, f32x4& a, f32x4& b) {
    a[0] = __builtin_bit_cast(float, w.x << 16); a[1] = __builtin_bit_cast(float, w.x & 0xffff0000u); a[2] = __builtin_bit_cast(float, w.y << 16); a[3] = __builtin_bit_cast(float, w.y & 0xffff0000u);
    b[0] = __builtin_bit_cast(float, w.z << 16); b[1] = __builtin_bit_cast(float, w.z & 0xffff0000u); b[2] = __builtin_bit_cast(float, w.w << 16); b[3] = __builtin_bit_cast(float, w.w & 0xffff0000u); }
#define EPI_ROWS(...) _Pragma("unroll") for (int ai = 0; ai < 2; ++ai) _Pragma("unroll") for (int m = 0; m < 4; ++m) { const size_t row = (size_t)(u.pm * BM + ai * HALF + wr * 64 + m * 16 + fr); __VA_ARGS__ }

struct EpInproj { static constexpr bool PERM = true; const float* b_in; bf16 *Q, *K, *V, *GU, *GV, *GA, *GB;
    __device__ __forceinline__ void operator()(const f32x4 (&acc)[2][2][4][2], const Unit& u, int wr, int wc, int fr, int fq) const {
        const int pn = u.pn; int kind, ld, ct; bf16* dst;
        if (pn < 2) { kind = 0; dst = Q; ld = FW; ct = pn; } else if (pn < 4) { kind = 1; dst = K; ld = FW; ct = pn - 2; } else if (pn < 6) { kind = 1; dst = V; ld = FW; ct = pn - 4; }
        else if (pn < 8) { kind = 2; dst = GU; ld = GW; ct = pn - 6; } else if (pn < 10) { kind = 2; dst = GV; ld = GW; ct = pn - 8; }
        else if (pn < 14) { kind = 3; dst = GA; ld = DM; ct = pn - 10; } else { kind = 3; dst = GB; ld = DM; ct = pn - 14; }
        const int cc = pn * BM, sc = (cc < OFF_F ? cc : cc + 8) + wc * 32 + 8 * fq;
        f32x4 bv[2][2];
_Pragma("unroll")
        for (int bj = 0; bj < 2; ++bj)
_Pragma("unroll")
            for (int n = 0; n < 2; ++n) bv[bj][n] = *(const f32x4*)(b_in + sc + bj * HALF + 4 * n);
        EPI_ROWS( bf16* rowp = dst + row * ld + ct * BM + wc * 32 + 8 * fq;
_Pragma("unroll")
            for (int bj = 0; bj < 2; ++bj) { f32x4 v0 = acc[ai][bj][m][0] + bv[bj][0], v1 = acc[ai][bj][m][1] + bv[bj][1];
                if (kind == 0) { v0 = v0 * QSCALE; v1 = v1 * QSCALE; }
                else if (kind == 2) {
_Pragma("unroll")
                    for (int i = 0; i < 4; ++i) { v0[i] = fgelu(v0[i]); v1[i] = fgelu(v1[i]); } }
                else if (kind == 3) {
_Pragma("unroll")
                    for (int i = 0; i < 4; ++i) { v0[i] = fsigmoid(v0[i]); v1[i] = fsigmoid(v1[i]); } }
                *(u32x4*)(rowp + bj * HALF) = pack8(v0, v1); } )
    } };
struct EpBrA { static constexpr bool PERM = true; const bf16* GA; float* TMPF;
    __device__ __forceinline__ void operator()(const f32x4 (&acc)[2][2][4][2], const Unit& u, int wr, int wc, int fr, int fq) const {
        EPI_ROWS( const size_t o = row * DM + u.pn * BM + wc * 32 + 8 * fq;
_Pragma("unroll")
            for (int bj = 0; bj < 2; ++bj) { f32x4 g0, g1; unpack8(*(const u32x4*)(GA + o + bj * HALF), g0, g1);
                *(f32x4*)(TMPF + o + bj * HALF) = g0 * acc[ai][bj][m][0]; *(f32x4*)(TMPF + o + bj * HALF + 4) = g1 * acc[ai][bj][m][1]; } )
    } };
struct EpBrB { static constexpr bool PERM = true; const bf16* GB; const float* TMPF; bf16* MRG;
    __device__ __forceinline__ void operator()(const f32x4 (&acc)[2][2][4][2], const Unit& u, int wr, int wc, int fr, int fq) const {
        EPI_ROWS( const size_t o = row * DM + u.pn * BM + wc * 32 + 8 * fq;
_Pragma("unroll")
            for (int bj = 0; bj < 2; ++bj) { f32x4 g0, g1; unpack8(*(const u32x4*)(GB + o + bj * HALF), g0, g1);
                const f32x4 t0 = *(const f32x4*)(TMPF + o + bj * HALF), t1 = *(const f32x4*)(TMPF + o + bj * HALF + 4);
                *(u32x4*)(MRG + o + bj * HALF) = pack8(t0 + g0 * acc[ai][bj][m][0], t1 + g1 * acc[ai][bj][m][1]); } )
    } };
struct EpOut { static constexpr bool PERM = false; const float* x; const float* b_out; float* out;
    __device__ __forceinline__ void operator()(const f32x4 (&acc)[2][2][4][2], const Unit& u, int wr, int wc, int fr, int fq) const {
        const int col0 = u.pn * BM + wc * 32 + 4 * fq;
        f32x4 bv[2][2];
_Pragma("unroll")
        for (int bj = 0; bj < 2; ++bj)
_Pragma("unroll")
            for (int n = 0; n < 2; ++n) bv[bj][n] = *(const f32x4*)(b_out + col0 + bj * HALF + n * 16);
        EPI_ROWS( const size_t o = row * DM + col0;
_Pragma("unroll")
            for (int bj = 0; bj < 2; ++bj)
_Pragma("unroll")
                for (int n = 0; n < 2; ++n) { const f32x4 xv = *(const f32x4*)(x + o + bj * HALF + n * 16); *(f32x4*)(out + o + bj * HALF + n * 16) = xv * ALPHA + acc[ai][bj][m][n] + bv[bj][n]; } )
    } };
struct EpGU { static constexpr bool PERM = true; const float* b_gu; bf16* HID;
    __device__ __forceinline__ void operator()(const f32x4 (&acc)[2][2][4][2], const Unit& u, int wr, int wc, int fr, int fq) const {
        const int j0 = u.pn * HALF + wc * 32 + 8 * fq; const float* bb = b_gu + (size_t)u.e * 2 * DFF + j0;
        f32x4 bg[2], bu[2];
_Pragma("unroll")
        for (int n = 0; n < 2; ++n) { bg[n] = *(const f32x4*)(bb + 4 * n); bu[n] = *(const f32x4*)(bb + DFF + 4 * n); }
        EPI_ROWS( f32x4 hv[2];
_Pragma("unroll")
            for (int n = 0; n < 2; ++n) { const f32x4 g = acc[ai][0][m][n] + bg[n], up = acc[ai][1][m][n] + bu[n];
_Pragma("unroll")
                for (int i = 0; i < 4; ++i) { const float gt = fminf(g[i], 7.f), uu = fminf(fmaxf(up[i], -7.f), 7.f); hv[n][i] = (uu + 1.f) * (gt * __builtin_amdgcn_rcpf(1.f + __builtin_amdgcn_exp2f(-1.702f * LOG2E * gt))); } }
            *(u32x4*)(HID + row * DFF + j0) = pack8(hv[0], hv[1]); )
    } };
struct EpDn { static constexpr bool PERM = true; const float* b_dn; bf16* Y;
    __device__ __forceinline__ void operator()(const f32x4 (&acc)[2][2][4][2], const Unit& u, int wr, int wc, int fr, int fq) const {
        const int col0 = u.pn * BM + wc * 32 + 8 * fq; const float* bb = b_dn + (size_t)u.e * DM + col0;
        f32x4 bv[2][2];
#pragma unroll
        for (int bj = 0; bj < 2; ++bj)
#pragma unroll
            for (int n = 0; n < 2; ++n) bv[bj][n] = *(const f32x4*)(bb + bj * HALF + 4 * n);
        EPI_ROWS( bf16* rowp = Y + row * DM + col0;
_Pragma("unroll")
            for (int bj = 0; bj < 2; ++bj) *(u32x4*)(rowp + bj * HALF) = pack8(acc[ai][bj][m][0] + bv[bj][0], acc[ai][bj][m][1] + bv[bj][1]); )
    } };
struct EpPG { static constexpr bool PERM = true; const float* b_pg; bf16* G;
    __device__ __forceinline__ void operator()(const f32x4 (&acc)[2][2][4][2], const Unit& u, int wr, int wc, int fr, int fq) const {
        const int col0 = u.pn * BM + wc * 32 + 8 * fq;
        f32x4 bv[2][2];
_Pragma("unroll")
        for (int bj = 0; bj < 2; ++bj)
_Pragma("unroll")
            for (int n = 0; n < 2; ++n) bv[bj][n] = *(const f32x4*)(b_pg + col0 + bj * HALF + 4 * n);
        EPI_ROWS( bf16* rowp = G + row * DM + col0;
_Pragma("unroll")
            for (int bj = 0; bj < 2; ++bj) { f32x4 v0 = acc[ai][bj][m][0] + bv[bj][0], v1 = acc[ai][bj][m][1] + bv[bj][1];
_Pragma("unroll")
                for (int i = 0; i < 4; ++i) { v0[i] = fsigmoid(v0[i]); v1[i] = fsigmoid(v1[i]); }
                *(u32x4*)(rowp + bj * HALF) = pack8(v0, v1); } )
    } };
struct EpPle { static constexpr bool PERM = false; const bf16* G; float* out;
    __device__ __forceinline__ void operator()(const f32x4 (&acc)[2][2][4][2], const Unit& u, int wr, int wc, int fr, int fq) const {
        const int col0 = u.pn * BM + wc * 32 + 4 * fq;
        EPI_ROWS( const size_t o = row * DM + col0;
_Pragma("unroll")
            for (int bj = 0; bj < 2; ++bj)
_Pragma("unroll")
                for (int n = 0; n < 2; ++n) { const size_t oo = o + bj * HALF + n * 16; const u32x2 gw = *(const u32x2*)(G + oo); f32x4 g;
                    g[0] = __builtin_bit_cast(float, gw.x << 16); g[1] = __builtin_bit_cast(float, gw.x & 0xffff0000u); g[2] = __builtin_bit_cast(float, gw.y << 16); g[3] = __builtin_bit_cast(float, gw.y & 0xffff0000u);
                    const f32x4 ov = *(const f32x4*)(out + oo); *(f32x4*)(out + oo) = ov * ALPHA + acc[ai][bj][m][n] * g; } )
    } };
}

#include <hip/hip_bf16.h>
#include <cmath>
namespace attn_body {
using bf16=__hip_bfloat16;
using bf16x8=__attribute__((ext_vector_type(8)))short;
using s16x4=__attribute__((ext_vector_type(4)))short;
using f32x16=__attribute__((ext_vector_type(16)))float;
using f32x4=__attribute__((ext_vector_type(4)))float;
using u32x4=__attribute__((ext_vector_type(4)))unsigned;
constexpr int BATCH=16,NHEAD=8,SEQ=2048,D=64,DM=NHEAD*D;
constexpr int NW=8,QBLK=32,QB=QBLK*NW,KVBLK=64,NQB=SEQ/QB;
constexpr int ATTN_PITCH=DM, ATTN_UNIT_ROWS=QB;
__device__ __forceinline__ int crow(int r,int hi){return (r&3)+8*(r>>2)+4*hi;}
#define SBAR() __builtin_amdgcn_sched_barrier(0)
__device__ __forceinline__ void cmask(f32x16&p0,f32x16&p1,int jb,int qrel,int hi){
  const float NEG=-INFINITY; int kb=64*jb+4*hi;
  #pragma unroll
  for(int r=0;r<16;++r){int kv=kb+(r&3)+8*(r>>2); if(kv>qrel)p0[r]=NEG; if(kv+32>qrel)p1[r]=NEG;}
}

constexpr int NSLOT=3, SLOTB=8192;
constexpr int LDS_K=0, LDS_V=NSLOT*SLOTB, LDS_WS=2*NSLOT*SLOTB, LDS_OST=LDS_WS+NW*64*4, LDS_CN=LDS_OST+NW*4096, LDS_BYTES=LDS_CN+SEQ*4;
constexpr float C2=0.125f*1.4426950408889634f;
__device__ __forceinline__ void glds16(const void*gsrc,unsigned lds_dst){unsigned keep;
  asm volatile("s_mov_b32 %0, m0\n\ts_mov_b32 m0, %2\n\ts_nop 0\n\tglobal_load_lds_dwordx4 %1, off\n\ts_mov_b32 m0, %0":"=&s"(keep):"v"(gsrc),"s"(lds_dst):"memory");}
__device__ __forceinline__ float max3f(float a,float b,float c){float r;asm("v_max3_f32 %0, %1, %2, %3":"=v"(r):"v"(a),"v"(b),"v"(c));return r;}
__device__ __forceinline__ float max2f(float a,float b){float r;asm("v_max_f32_e32 %0, %1, %2":"=v"(r):"v"(a),"v"(b));return r;}
__device__ __forceinline__ float fadd_s(float a,float b){float r;asm("v_add_f32_e32 %0, %1, %2":"=v"(r):"v"(a),"v"(b));return r;}
__device__ __forceinline__ float fsub_s(float a,float b){float r;asm("v_sub_f32_e32 %0, %1, %2":"=v"(r):"v"(a),"v"(b));return r;}
typedef float f32x2_t __attribute__((ext_vector_type(2))); typedef __bf16 bf16x2_t __attribute__((ext_vector_type(2)));
__device__ __forceinline__ unsigned cvtpk_s(float lo,float hi){f32x2_t v={lo,hi};bf16x2_t b=__builtin_convertvector(v,bf16x2_t);return __builtin_bit_cast(unsigned,b);}
#define WAIT_BAR(N) asm volatile("s_waitcnt vmcnt(" #N ") lgkmcnt(0)\n\ts_barrier":::"memory")

__device__ __forceinline__ void qkt(f32x16&p0,f32x16&p1,const char*Kslot,const bf16x8*qr,int r32,int hi){
  const char*kb=Kslot+hi*1024+r32*16;
  #pragma unroll
  for(int d0=0;d0<4;++d0){
    const bf16x8 b0=*reinterpret_cast<const bf16x8*>(kb+d0*2048);
    const bf16x8 b1=*reinterpret_cast<const bf16x8*>(kb+d0*2048+512);
    {p0=__builtin_amdgcn_mfma_f32_32x32x16_bf16(b0,qr[d0],p0,0,0,0);p1=__builtin_amdgcn_mfma_f32_32x32x16_bf16(b1,qr[d0],p1,0,0,0);}}
}
typedef __attribute__((address_space(3))) const char* lds_cptr;
typedef short v4i16_t __attribute__((ext_vector_type(4)));
__device__ __forceinline__ void kload8(bf16x8*kf,lds_cptr kp){
  kf[0]=*(const __attribute__((address_space(3))) bf16x8*)(kp);      kf[1]=*(const __attribute__((address_space(3))) bf16x8*)(kp+512);
  kf[2]=*(const __attribute__((address_space(3))) bf16x8*)(kp+2048); kf[3]=*(const __attribute__((address_space(3))) bf16x8*)(kp+2560);
  kf[4]=*(const __attribute__((address_space(3))) bf16x8*)(kp+4096); kf[5]=*(const __attribute__((address_space(3))) bf16x8*)(kp+4608);
  kf[6]=*(const __attribute__((address_space(3))) bf16x8*)(kp+6144); kf[7]=*(const __attribute__((address_space(3))) bf16x8*)(kp+6656);
}
__device__ __forceinline__ void kload2(bf16x8*kf,lds_cptr kp,int j){ kf[2*j]=*(const __attribute__((address_space(3))) bf16x8*)(kp+j*2048); kf[2*j+1]=*(const __attribute__((address_space(3))) bf16x8*)(kp+j*2048+512); }
__device__ __forceinline__ s16x4 vtr(lds_cptr p){ return __builtin_bit_cast(s16x4,__builtin_amdgcn_ds_read_tr16_b64_v4i16((__attribute__((address_space(3))) v4i16_t*)p)); }
__device__ __forceinline__ float rowmax(const f32x16&p0,const f32x16&p1){
  float a=max3f(p0[0],p0[1],p1[0]),b=max3f(p0[2],p0[3],p1[1]);a=max3f(a,p1[2],p1[3]);
  #pragma unroll
  for(int r=4;r<16;r+=4){a=max3f(a,p0[r],p0[r+1]);b=max3f(b,p0[r+2],p0[r+3]);a=max3f(a,p1[r],p1[r+1]);b=max3f(b,p1[r+2],p1[r+3]);}
  const float m=max2f(a,b);
  auto rr=__builtin_amdgcn_permlane32_swap(__float_as_uint(m),__float_as_uint(m),false,false);
  return max2f(__uint_as_float(rr[0]),__uint_as_float(rr[1]));
}
__device__ __forceinline__ void pv(f32x16*o,int vb,bf16x8 pa0,bf16x8 pa1,bf16x8 pa2,bf16x8 pa3){
  #pragma unroll
  for(int d0=0;d0<2;++d0){s16x4 lo[4],hi[4];
    #pragma unroll
    for(int ks=0;ks<4;++ks){
      asm volatile("ds_read_b64_tr_b16 %0,%1 offset:%c2":"=&v"(lo[ks]):"v"(vb),"i"(d0*4096+ks*1024):"memory");
      asm volatile("ds_read_b64_tr_b16 %0,%1 offset:%c2":"=&v"(hi[ks]):"v"(vb),"i"(d0*4096+ks*1024+512):"memory");}
    asm volatile("s_waitcnt lgkmcnt(0)":::"memory");SBAR();
    #define PK(k) (bf16x8){lo[k][0],lo[k][1],lo[k][2],lo[k][3],hi[k][0],hi[k][1],hi[k][2],hi[k][3]}
    o[d0]=__builtin_amdgcn_mfma_f32_32x32x16_bf16(pa0,PK(0),o[d0],0,0,0);
    o[d0]=__builtin_amdgcn_mfma_f32_32x32x16_bf16(pa1,PK(1),o[d0],0,0,0);
    o[d0]=__builtin_amdgcn_mfma_f32_32x32x16_bf16(pa2,PK(2),o[d0],0,0,0);
    o[d0]=__builtin_amdgcn_mfma_f32_32x32x16_bf16(pa3,PK(3),o[d0],0,0,0);
    #undef PK
  }
}

#ifndef ATTN_STORE16
#define ATTN_STORE16(p,v) (*(u32x4*)(p)=(v))
#endif
template<int THRL> __device__ __forceinline__ void attn_unit(int b,int h,int qb,const bf16*Q,const bf16*__restrict__ K,const bf16*__restrict__ V,bf16*O,const float*CNrow,char*shm){
  int tid_=threadIdx.x; asm volatile("":"+v"(tid_)); const int tid=tid_,lane=tid&63,r32=lane&31,hi=lane>>5; const int wid=__builtin_amdgcn_readfirstlane(tid>>6);
  const long rowbase=(long)b*SEQ; const int q0=qb*QB;
  const bf16*Qw=Q+(rowbase+q0+wid*QBLK)*DM+h*D;
  const bf16*Kh=K+rowbase*DM+h*D,*Vh=V+rowbase*DM+h*D;
  typedef __attribute__((address_space(3))) char* lds_wptr; const lds_wptr shm3=(lds_wptr)shm; const unsigned lds0=(unsigned)(uintptr_t)shm;
  float*wsf=(float*)(shm+LDS_WS)+wid*64;
  const bf16*ksrc=Kh+(long)lane*DM+wid*8;
  const bf16*vsrc=Vh+(long)(16*(wid&3)+(lane>>2))*DM+(wid>>2)*32+(lane&3)*8;
  const unsigned kdst=lds0+LDS_K+wid*1024, vdst=lds0+LDS_V+wid*1024;
  #define DMA_K(t,slot) glds16(ksrc+(long)(t)*KVBLK*DM,(unsigned)__builtin_amdgcn_readfirstlane(kdst+(slot)))
  #define DMA_V(t,slot) glds16(vsrc+(long)(t)*KVBLK*DM,(unsigned)__builtin_amdgcn_readfirstlane(vdst+(slot)))
  const int vb0=(int)(lds0+LDS_V)+((lane>>4)&1)*32+(lane&3)*8+(4*hi+((lane&15)>>2))*64;
  const char*Kbase=shm+LDS_K; bf16x8 kf[8];
  const lds_cptr kp0=shm3+LDS_K+hi*1024+r32*16; const lds_cptr vp0=shm3+LDS_V+((lane>>4)&1)*32+(lane&3)*8+(4*hi+((lane&15)>>2))*64;
  const int NT=(q0+QB)/KVBLK;
  { typedef __attribute__((address_space(3))) f32x4* lds_f4w; const int i4=tid*4; if(i4<q0+QB){ const f32x4 v_=*(const f32x4*)(CNrow+i4); *(lds_f4w)(shm3+LDS_CN+i4*4)=-v_; } asm volatile("s_waitcnt vmcnt(0) lgkmcnt(0)":::"memory"); }
  typedef const __attribute__((address_space(3))) f32x4* lds_f4r;
  #define CINIT(C0,C1,t) do{ const lds_f4r kp_=(lds_f4r)(shm3+LDS_CN+256*(t)+16*hi); _Pragma("unroll") for(int g_=0;g_<4;++g_){ const f32x4 a_=kp_[2*g_], b_=kp_[2*g_+8]; _Pragma("unroll") for(int e_=0;e_<4;++e_){ C0[4*g_+e_]=a_[e_]-mhat; C1[4*g_+e_]=b_[e_]-mhat; } } }while(0)
  DMA_K(0,0);DMA_V(0,0);DMA_K(1,SLOTB);
  bf16x8 qr[4];
  #pragma unroll
  for(int d0=0;d0<4;++d0)qr[d0]=*reinterpret_cast<const bf16x8*>(&Qw[(long)r32*DM+d0*16+hi*8]);
  float mhat=0.f,l_reg=0.f;f32x16 o[2];o[0]=f32x16{};o[1]=f32x16{};
  const int qrel=wid*QBLK+r32;
  #define CMASK(P0,P1,t) do{int jb_=(t)-(NT-4); if(jb_>=0)cmask(P0,P1,jb_,qrel,hi);}while(0)
  bool resc=false;
  #define START(P0,P1) do{ const float rm=rowmax(P0,P1); resc=false; \
    { const float dl=rm; mhat=fadd_s(mhat,dl); \
      _Pragma("unroll") for(int r=0;r<16;++r){P0[r]=fsub_s(P0[r],dl);P1[r]=fsub_s(P1[r],dl);} \
      } \
    _Pragma("unroll") for(int r=0;r<16;++r)P0[r]=__builtin_amdgcn_exp2f(P0[r]); }while(0)
  #define RESC() do{ if(resc){ asm volatile("s_waitcnt lgkmcnt(0)":::"memory"); \
      _Pragma("unroll") for(int d_=0;d_<2;++d_) _Pragma("unroll") for(int r=0;r<16;++r)o[d_][r]*=wsf[crow(r,hi)]; } }while(0)
  f32x16 pA0,pA1,pB0,pB1;
  int sl_prev=0,sl_cur=0,sl_next=SLOTB;
  #define ROT() do{sl_prev=sl_cur;sl_cur=sl_next;sl_next=(sl_next==(NSLOT-1)*SLOTB)?0:sl_next+SLOTB;}while(0)
  DMA_K(2,2*SLOTB);
  WAIT_BAR(3);
  CINIT(pA0,pA1,0); qkt(pA0,pA1,Kbase,qr,r32,hi);asm volatile("s_nop 15\n\ts_nop 7":"+v"(pA0),"+v"(pA1));CMASK(pA0,pA1,0);
  START(pA0,pA1);
  _Pragma("unroll") for(int r=0;r<16;++r)pA1[r]=__builtin_amdgcn_exp2f(pA1[r]);
  WAIT_BAR(0);
  DMA_K(3,0);DMA_V(1,SLOTB);
  ROT();
  kload8(kf,kp0+sl_cur);
  WAIT_BAR(2);
  s16x4 vlo[8],vhi[8]; u32x4 pw0,pw1,pw2,pw3;
  #define PKW(P,B) cvtpk_s(P[B],P[B+1])
  #define PAF(k) __builtin_bit_cast(bf16x8,pw##k)
  #define VFR(i) (bf16x8){vlo[i][0],vlo[i][1],vlo[i][2],vlo[i][3],vhi[i][0],vhi[i][1],vhi[i][2],vhi[i][3]}
  #define PIN(x) asm volatile("":"+v"(x))
  #define MX3(a,b,c) __builtin_fmaxf(__builtin_fmaxf((a),(b)),(c))
  #define GAPA(MF,A0,A1,A2,A3,W0,W1,PW) do{ MF; sacc+=A0; sacc+=A1; sacc+=A2; sacc+=A3; PIN(sacc); W0; W1; PIN(PW); SBAR(); }while(0)
  #define EX(v) __builtin_amdgcn_exp2f(v)
  #define GAPB(MF,X,B) do{ MF; X[B]=EX(X[B]); X[B+1]=EX(X[B+1]); X[B+2]=EX(X[B+2]); X[B+3]=EX(X[B+3]); PIN(X); SBAR(); }while(0)
  #define VRD(i) do{ vlo[i]=vtr(vp_+(((i)>>2)*4096+((i)&3)*1024)); vhi[i]=vtr(vp_+(((i)>>2)*4096+((i)&3)*1024+512)); }while(0)
  #define KRD(G,j) do{ if(G){ kload2(kf,kp0+sl_next,j); SBAR(); } }while(0)
  #define STEP(C0,C1,P0,P1,t,GK,GV,GL) do{ SBAR(); CINIT(C0,C1,t); SBAR(); \
    const lds_cptr vp_=vp0+sl_prev; \
    VRD(0); SBAR(); float sacc=(P0[0]+P0[1]); \
    GAPA(C0=__builtin_amdgcn_mfma_f32_32x32x16_bf16(kf[0],qr[0],C0,0,0,0), P0[2],P0[3],P0[4],P0[5],     pw0[0]=PKW(P0,0), pw0[1]=PKW(P0,2), pw0); \
    VRD(4); SBAR(); GAPA(C1=__builtin_amdgcn_mfma_f32_32x32x16_bf16(kf[1],qr[0],C1,0,0,0), P0[6],P0[7],P0[8],P0[9],     pw0[2]=PKW(P0,4), pw0[3]=PKW(P0,6), pw0); \
    VRD(1); SBAR(); GAPA(C0=__builtin_amdgcn_mfma_f32_32x32x16_bf16(kf[2],qr[1],C0,0,0,0),   P0[10],P0[11],P0[12],P0[13], pw1[0]=PKW(P0,8), pw1[1]=PKW(P0,10), pw1); \
    VRD(5); SBAR(); GAPA(C1=__builtin_amdgcn_mfma_f32_32x32x16_bf16(kf[3],qr[1],C1,0,0,0),   P0[14],P0[15],P1[0],P1[1],   pw1[2]=PKW(P0,12),pw1[3]=PKW(P0,14), pw1); \
    VRD(2); SBAR(); GAPA(C0=__builtin_amdgcn_mfma_f32_32x32x16_bf16(kf[4],qr[2],C0,0,0,0),   P1[2],P1[3],P1[4],P1[5],     pw2[0]=PKW(P1,0), pw2[1]=PKW(P1,2), pw2); \
    VRD(6); SBAR(); GAPA(C1=__builtin_amdgcn_mfma_f32_32x32x16_bf16(kf[5],qr[2],C1,0,0,0),   P1[6],P1[7],P1[8],P1[9],     pw2[2]=PKW(P1,4), pw2[3]=PKW(P1,6), pw2); \
    VRD(3); SBAR(); GAPA(C0=__builtin_amdgcn_mfma_f32_32x32x16_bf16(kf[6],qr[3],C0,0,0,0),   P1[10],P1[11],P1[12],P1[13], pw3[0]=PKW(P1,8), pw3[1]=PKW(P1,10), pw3); \
    VRD(7); SBAR(); GAPA(C1=__builtin_amdgcn_mfma_f32_32x32x16_bf16(kf[7],qr[3],C1,0,0,0),   P1[14],P1[15],0.f,0.f,       pw3[2]=PKW(P1,12),pw3[3]=PKW(P1,14), pw3); \
    l_reg+=sacc; \
    if(GK){DMA_K((t)+3,sl_cur);} if(GV){DMA_V((t)+1,sl_next);} \
    CMASK(C0,C1,t); \
    { float a=MX3(C0[0],C0[1],C1[0]),b=MX3(C0[2],C0[3],C1[1]); a=MX3(a,C1[2],C1[3]); \
      _Pragma("unroll") for(int r=4;r<16;r+=4){a=MX3(a,C0[r],C0[r+1]);b=MX3(b,C0[r+2],C0[r+3]);a=MX3(a,C1[r],C1[r+1]);b=MX3(b,C1[r+2],C1[r+3]);} \
      float rm=__builtin_fmaxf(a,b); { auto rr=__builtin_amdgcn_permlane32_swap(__float_as_uint(rm),__float_as_uint(rm),false,false); rm=__builtin_fmaxf(__uint_as_float(rr[0]),__uint_as_float(rr[1])); } \
      resc=false; \
      if(__builtin_expect(__any(rm>(float)THRL),0)){ const float dl=__builtin_fmaxf(rm,0.f); mhat+=dl; \
        _Pragma("unroll") for(int r=0;r<16;++r){C0[r]-=dl;C1[r]-=dl;} \
        const float f=__builtin_amdgcn_exp2f(-dl); l_reg*=f; if(hi==0)wsf[r32]=f; resc=true; } } \
    SBAR(); \
    GAPB(o[0]=__builtin_amdgcn_mfma_f32_32x32x16_bf16(PAF(0),VFR(0),o[0],0,0,0), C0,0); \
    GAPB(o[1]=__builtin_amdgcn_mfma_f32_32x32x16_bf16(PAF(0),VFR(4),o[1],0,0,0), C0,4); \
    KRD(GL,0); GAPB(o[0]=__builtin_amdgcn_mfma_f32_32x32x16_bf16(PAF(1),VFR(1),o[0],0,0,0), C0,8); \
    KRD(GL,1); GAPB(o[1]=__builtin_amdgcn_mfma_f32_32x32x16_bf16(PAF(1),VFR(5),o[1],0,0,0), C0,12); \
    KRD(GL,2); GAPB(o[0]=__builtin_amdgcn_mfma_f32_32x32x16_bf16(PAF(2),VFR(2),o[0],0,0,0), C1,0); \
    KRD(GL,3); GAPB(o[1]=__builtin_amdgcn_mfma_f32_32x32x16_bf16(PAF(2),VFR(6),o[1],0,0,0), C1,4); \
    GAPB(o[0]=__builtin_amdgcn_mfma_f32_32x32x16_bf16(PAF(3),VFR(3),o[0],0,0,0), C1,8); \
    GAPB(o[1]=__builtin_amdgcn_mfma_f32_32x32x16_bf16(PAF(3),VFR(7),o[1],0,0,0), C1,12); \
    }while(0)
  int t=1;
  #undef CMASK
  #define CMASK(P0,P1,t) do{}while(0)
  for(;t+5<NT;t+=2){
    STEP(pB0,pB1,pA0,pA1,t,true,true,true);     WAIT_BAR(2); RESC(); ROT();
    STEP(pA0,pA1,pB0,pB1,t+1,true,true,true);   WAIT_BAR(2); RESC(); ROT();
  }
  #undef CMASK
  #define CMASK(P0,P1,t) do{int jb_=(t)-(NT-4); if(jb_>=0)cmask(P0,P1,jb_,qrel,hi);}while(0)
  #define ENDW(tt) do{ if((tt)+3<NT){WAIT_BAR(2);} else if((tt)+2<NT){WAIT_BAR(1);} else {WAIT_BAR(0);} }while(0)
  for(;t+1<NT;t+=2){
    STEP(pB0,pB1,pA0,pA1,t,(t+3<NT),(t+1<NT),(t+1<NT));       ENDW(t);   RESC(); ROT();
    STEP(pA0,pA1,pB0,pB1,t+1,(t+4<NT),(t+2<NT),(t+2<NT));     ENDW(t+1); RESC(); ROT();
  }
  STEP(pB0,pB1,pA0,pA1,NT-1,false,false,false); RESC();
  { float sacc=pB0[0]+pB0[1]; _Pragma("unroll") for(int r=2;r<16;++r)sacc+=pB0[r]; _Pragma("unroll") for(int r=0;r<16;++r)sacc+=pB1[r]; l_reg+=sacc;
    pw0=(u32x4){PKW(pB0,0),PKW(pB0,2),PKW(pB0,4),PKW(pB0,6)};pw1=(u32x4){PKW(pB0,8),PKW(pB0,10),PKW(pB0,12),PKW(pB0,14)};pw2=(u32x4){PKW(pB1,0),PKW(pB1,2),PKW(pB1,4),PKW(pB1,6)};pw3=(u32x4){PKW(pB1,8),PKW(pB1,10),PKW(pB1,12),PKW(pB1,14)};
    SBAR(); pv(o,vb0+sl_cur,PAF(0),PAF(1),PAF(2),PAF(3)); }
  #undef PKW
  #undef PAF
  #undef VFR
  #undef PIN
  #undef MX3
  #undef GAPA
  #undef GAPB
  #undef EX
  #undef VRD
  #undef KRD
  #undef STEP
  #undef ENDW
  {auto rr=__builtin_amdgcn_permlane32_swap(__float_as_uint(l_reg),__float_as_uint(l_reg),false,false);l_reg=__uint_as_float(rr[0])+__uint_as_float(rr[1]);}
  if(hi==0)wsf[32+r32]=l_reg;asm volatile("s_waitcnt lgkmcnt(0)":::"memory");
  float rli[16];
  #pragma unroll
  for(int r=0;r<16;++r)rli[r]=__builtin_amdgcn_rcpf(wsf[32+crow(r,hi)]);
  bf16*Ow=O+(rowbase+q0+wid*QBLK)*DM+h*D;
  { bf16*stg=(bf16*)(shm+LDS_OST)+wid*2048;
    #pragma unroll
    for(int r=0;r<16;++r){const int orow=crow(r,hi);
      #pragma unroll
      for(int d0=0;d0<2;++d0)stg[orow*64+d0*32+r32]=__float2bfloat16(o[d0][r]*rli[r]);}
    asm volatile("s_waitcnt lgkmcnt(0)":::"memory");
    #pragma unroll
    for(int i=0;i<4;++i){const int row=i*8+(lane>>3),ch=lane&7; const u32x4 v=*(const u32x4*)(stg+row*64+ch*8); ATTN_STORE16(Ow+(long)row*DM+ch*8,v);} }
  asm volatile("s_waitcnt lgkmcnt(0)\n\ts_barrier":::"memory");
  #undef DMA_K
  #undef CINIT
  #undef DMA_V
  #undef CMASK
  #undef START
  #undef RESC
  #undef ROT
}
constexpr int ATTN_LDS_BYTES=LDS_BYTES;
struct AttnTensors { const bf16* Q; const bf16* K; const bf16* V; bf16* O; const float* CN; };
struct AttnUnit { int bh; int qb; };
struct StaticOrder {
  int vcu;
  __device__ __forceinline__ explicit StaticOrder(int grid,int block):vcu((block%8)*(grid/8)+block/8){}
  __device__ __forceinline__ bool next(int i,AttnUnit&u)const{ if(i>=4)return false; const int s=2*(vcu&1)+(i>>1); u.bh=vcu>>1; u.qb=(i&1)?7-s:s; return true; }
};
template<class Sched,int THRL=8> __device__ __forceinline__ void attn_phase(char*lds,const AttnTensors&T,const Sched&S){
  AttnUnit u;
  for(int i=0;S.next(i,u);++i){ attn_unit<THRL>(u.bh/NHEAD,u.bh%NHEAD,u.qb,T.Q,T.K,T.V,T.O,T.CN+(size_t)u.bh*SEQ,lds); }
}
#undef SBAR
#undef WAIT_BAR
}

#define XB_TMO      128
#define XB_XCNT(j)  (256  + 64 * (j))
#define XB_XSUB(j)  (1280 + 64 * (j))
#define XB_XGEN(j)  (2304 + 64 * (j))
#define XB_TOP      3328
#define XB_TOPGEN   3392
#define XCD_BAR_WORDS 3456
#define XB_SPIN_CAP (1u << 18)
__device__ __forceinline__ unsigned xb_ld(unsigned* p)              { return __hip_atomic_load(p, __ATOMIC_RELAXED, __HIP_MEMORY_SCOPE_AGENT); }
__device__ __forceinline__ unsigned xb_add(unsigned* p, unsigned v) { return __hip_atomic_fetch_add(p, v, __ATOMIC_RELAXED, __HIP_MEMORY_SCOPE_AGENT); }
__device__ __forceinline__ unsigned xb_xcc_id() { return (unsigned)__builtin_amdgcn_s_getreg((3 << 11) | 20) & 0xFu; }
#define XB_SPIN(cond, bar) do { unsigned _sp = 0; while (cond) { __builtin_amdgcn_s_sleep(1); \
    if ((++_sp & 255u) == 0u) { if (xb_ld(&(bar)[XB_TMO])) break; if (_sp > XB_SPIN_CAP) { atomicAdd(&(bar)[XB_TMO], 1u); break; } } } } while (0)
struct XcdBarrier { unsigned* bar; unsigned x; volatile LAS unsigned* st; };
__device__ __forceinline__ XcdBarrier xcd_barrier_post(unsigned* bar, volatile LAS unsigned* st) {
    XcdBarrier b; b.bar = bar; b.x = xb_xcc_id(); b.st = st;
    if (threadIdx.x == 0) (void)xb_add(&bar[XB_XCNT(b.x)], 1u);
    return b;
}
__device__ __forceinline__ void xcd_barrier_complete(unsigned* bar, unsigned x, unsigned& nloc, unsigned& nx) {
    const unsigned G = gridDim.x * gridDim.y * gridDim.z;
    unsigned sum, cnt, mine, sp = 0u;
    for (;;) {
        sum = 0u; cnt = 0u; mine = 0u;
#pragma unroll
        for (unsigned j = 0; j < 16; ++j) { const unsigned c = xb_ld(&bar[XB_XCNT(j)]); sum += c; cnt += (c > 0u) ? 1u : 0u; mine = (j == x) ? c : mine; }
        if (sum == G) break;
        __builtin_amdgcn_s_sleep(1);
        if ((++sp & 255u) == 0u) { if (xb_ld(&bar[XB_TMO])) break; if (sp > XB_SPIN_CAP) { atomicAdd(&bar[XB_TMO], 1u); break; } }
    }
    nloc = mine > 0u ? mine : 1u; nx = cnt > 0u ? cnt : 1u;
}
__device__ __forceinline__ void xcd_barrier(const XcdBarrier& b) {
    asm volatile("s_waitcnt vmcnt(0)" ::: "memory");
    __syncthreads();
    if (threadIdx.x == 0) {
        unsigned* bar = b.bar;
        __builtin_amdgcn_s_waitcnt(0);
        unsigned nloc = b.st[0], nx = b.st[1];
        if (nloc == 0u) { xcd_barrier_complete(bar, b.x, nloc, nx); b.st[0] = nloc; b.st[1] = nx; }
        const unsigned old = xb_add(&bar[XB_XSUB(b.x)], 1u);
        const unsigned gen = old / nloc;
        if (old + 1u == (gen + 1u) * nloc) {
            __builtin_amdgcn_fence(__ATOMIC_RELEASE, "agent");
            asm volatile("s_waitcnt vmcnt(0)" ::: "memory");
            const unsigned og = xb_add(&bar[XB_TOP], 1u);
            const unsigned tg = og / nx;
            if (og + 1u == (tg + 1u) * nx) xb_add(&bar[XB_TOPGEN], 1u);
            else XB_SPIN(xb_ld(&bar[XB_TOPGEN]) == tg, bar);
            __builtin_amdgcn_fence(__ATOMIC_ACQUIRE, "agent");
            xb_add(&bar[XB_XGEN(b.x)], 1u);
            asm volatile("s_waitcnt vmcnt(0)" ::: "memory");
        } else {
            XB_SPIN(xb_ld(&bar[XB_XGEN(b.x)]) == gen, bar);
            __builtin_amdgcn_fence(__ATOMIC_ACQUIRE, "agent");
            asm volatile("s_waitcnt vmcnt(0)" ::: "memory");
        }
    }
    __syncthreads();
}

constexpr int NPHASE = 12;
constexpr int CW_BAR = 4096;
constexpr int N_BAR_REGIONS = 16;
static_assert((CW_BAR + N_BAR_REGIONS * XCD_BAR_WORDS) * 4 <= (int)CTL_BYTES, "CTL words inside the memset region");
constexpr int SGU_ST_OFF = LDSCTL_OFF + 2048;
static_assert(attn_body::LDS_BYTES <= RING_BYTES && SGU_ST_OFF + 1024 <= LDS_BYTES, "LDS map");
#define LDS_WAIT() asm volatile("s_waitcnt lgkmcnt(0)" ::: "memory")
__device__ __forceinline__ int lane_id_fresh() { int l = (int)__builtin_amdgcn_mbcnt_hi(~0u, __builtin_amdgcn_mbcnt_lo(~0u, 0u)); asm volatile("" : "+v"(l)); return l; }
#define LANE_ID() lane_id_fresh()
#define TID() (F.wave * 64 + LANE_ID())

struct MArgs { const float* in[27]; float* out; unsigned char* ws; int ph_lo, ph_hi, li, pad; };
struct Frame {
    LAS unsigned char* lds; int wave, G, vcu;
    const float *x, *p, *w_in, *b_in, *gln_g, *gln_b, *w_sp, *b_sp, *w_a, *w_b, *w_o, *b_o, *ln1g, *ln1b, *w_r, *b_r, *w_gu, *b_gu, *w_dn, *b_dn, *ln2g, *ln2b, *w_ple, *w_pg, *b_pg, *ln3g, *ln3b;
    float* out; unsigned* ctl;
    bf16 *WIN, *WA, *WB, *WO, *WPG, *WPLE, *WSP, *WRH, *WRL, *WGU, *WDN, *HB, *PB;
    float *FLOG, *CN, *TOPG, *ROWG; int *POS, *LIST, *ROWTOK, *TILEE;
    bf16 *XB, *Q, *K, *V, *GU, *GV, *GA, *GB, *ATT, *SGU, *MRG, *HID, *Y, *HL; float* TMPF;
};

template <int MODE> __device__ __forceinline__ void tr_item(const float* W, int K, int Nsrc, bf16* WT, LAS float* scr, int kb, int nb, int lane) {
    const int k0 = 64 * kb, n0 = 32 * nb, cs = colmap<MODE>(n0);
    float tmp[32];
#pragma unroll
    for (int i = 0; i < 32; ++i) tmp[i] = W[(size_t)(k0 + 2 * i + (lane >> 5)) * Nsrc + cs + (lane & 31)];
#pragma unroll
    for (int i = 0; i < 32; ++i) scr[(2 * i + (lane >> 5)) * 33 + (lane & 31)] = tmp[i];
    LDS_WAIT(); asm volatile("" ::: "memory");
    const int c = lane & 7;
#pragma unroll
    for (int j = 0; j < 4; ++j) { const int n = (lane >> 3) + 8 * j; const LAS float* s = scr + (8 * c) * 33 + n;
        u32x4 o; o.x = pk2(s[0 * 33], s[1 * 33]); o.y = pk2(s[2 * 33], s[3 * 33]); o.z = pk2(s[4 * 33], s[5 * 33]); o.w = pk2(s[6 * 33], s[7 * 33]);
        *(u32x4*)(WT + (size_t)(n0 + n) * K + k0 + 8 * c) = o; }
    LDS_WAIT(); asm volatile("" ::: "memory");
}
template <int MODE> __device__ __forceinline__ void tr_matrix(const float* W, int K, int Nsrc, int Nout, int nbatch, bf16* WT, LAS float* scr, int gw, int NGW, int& rot, int lane) {
    const int nkb = K / 64, nnb = Nout / 32, per = nkb * nnb, total = per * nbatch;
    int first = gw - rot; if (first < 0) first += NGW;
    for (int it = first; it < total; it += NGW) { const int b = it / per, r = it % per;
        tr_item<MODE>(W + (size_t)b * K * Nsrc, K, Nsrc, WT + (size_t)b * Nout * K, scr, r / nnb, r % nnb, lane); }
    rot = (rot + total) % NGW;
}
__device__ __forceinline__ float log_sigmoid(float f) { return fminf(f, 0.f) - log1pf(expf(-fabsf(f))); }

__device__ __forceinline__ void p0_prologue(Frame& F) {
    LAS float* scr = (LAS float*)(F.lds + F.wave * 16384);
    const int gw = F.vcu * NWAVES + F.wave, NGW = F.G * NWAVES, lane = LANE_ID(); int rot = 0;
    tr_matrix<2>(F.w_gu, DM, 2 * DFF, 2 * DFF, NE, F.WGU, scr, gw, NGW, rot, lane);
    tr_matrix<0>(F.w_dn, DFF, DM, DM, NE, F.WDN, scr, gw, NGW, rot, lane);
    tr_matrix<1>(F.w_in, DM, DIN, DINC, 1, F.WIN, scr, gw, NGW, rot, lane);
    tr_matrix<0>(F.w_a, FW, DM, DM, 1, F.WA, scr, gw, NGW, rot, lane);
    tr_matrix<0>(F.w_b, GW, DM, DM, 1, F.WB, scr, gw, NGW, rot, lane);
    tr_matrix<0>(F.w_o, DM, DM, DM, 1, F.WO, scr, gw, NGW, rot, lane);
    tr_matrix<0>(F.w_pg, DM, DM, DM, 1, F.WPG, scr, gw, NGW, rot, lane);
    tr_matrix<0>(F.w_ple, PLE, DM, DM, 1, F.WPLE, scr, gw, NGW, rot, lane);
    const int gt = F.vcu * (NWAVES * 64) + TID(), NGT = F.G * NWAVES * 64;
    for (int i = gt; i < NGRP * CHUNK * CHUNK; i += NGT) { const int s = i & 127, t = (i >> 7) & 127; F.WSP[i] = s <= t ? f2bf(F.w_sp[i]) : (bf16)0; }
    for (int i = gt; i < NE * DM; i += NGT) { const int e = i >> 10, k = i & 1023; const float w = F.w_r[(size_t)k * NE + e]; const bf16 hi = f2bf(w); F.WRH[i] = hi; F.WRL[i] = f2bf(w - bf2f(hi)); }
#pragma unroll 4
    for (size_t i = (size_t)gt * 4; i < (size_t)T * PLE; i += (size_t)NGT * 4) { const f32x4 v = *(const f32x4*)(F.p + i); u32x2 w; w.x = pk2(v[0], v[1]); w.y = pk2(v[2], v[3]); *(u32x2*)(F.PB + i) = w; }
    f32x4 wf[16][2];
#pragma unroll
    for (int j = 0; j < 4; ++j)
#pragma unroll
        for (int c = 0; c < 4; ++c) { const float* wr = F.w_in + (size_t)(4 * lane + 256 * j + c) * DIN + OFF_F; wf[4 * j + c][0] = *(const f32x4*)wr; wf[4 * j + c][1] = *(const f32x4*)(wr + 4); }
    for (int t0 = gw; t0 < T; t0 += 2 * NGW) {
        f32x4 v[2][4];
#pragma unroll
        for (int rr = 0; rr < 2; ++rr)
#pragma unroll
            for (int j = 0; j < 4; ++j) v[rr][j] = *(const f32x4*)(F.x + (size_t)(t0 + rr * NGW) * DM + 4 * lane + 256 * j);
        f32x4 f[2][2];
#pragma unroll
        for (int rr = 0; rr < 2; ++rr) { f[rr][0] = (f32x4){0.f, 0.f, 0.f, 0.f}; f[rr][1] = (f32x4){0.f, 0.f, 0.f, 0.f}; }
#pragma unroll
        for (int j = 0; j < 4; ++j)
#pragma unroll
            for (int c = 0; c < 4; ++c)
#pragma unroll
                for (int rr = 0; rr < 2; ++rr) { const float xv = v[rr][j][c]; f[rr][0] += wf[4 * j + c][0] * xv; f[rr][1] += wf[4 * j + c][1] * xv; }
#pragma unroll
        for (int rr = 0; rr < 2; ++rr) { const size_t t = (size_t)(t0 + rr * NGW);
#pragma unroll
            for (int j = 0; j < 4; ++j) { u32x2 w; w.x = pk2(v[rr][j][0], v[rr][j][1]); w.y = pk2(v[rr][j][2], v[rr][j][3]); *(u32x2*)(F.XB + t * DM + 4 * lane + 256 * j) = w; }
#pragma unroll
            for (int h = 0; h < 4; ++h) { f[rr][0][h] = wave_sum(f[rr][0][h]); f[rr][1][h] = wave_sum(f[rr][1][h]); }
            if (lane == 0) { float* o = F.FLOG + t * 8; const float* bb = F.b_in + OFF_F;
                *(f32x4*)o = f[rr][0] + *(const f32x4*)bb; *(f32x4*)(o + 4) = f[rr][1] + *(const f32x4*)(bb + 4); } }
    }
}
__device__ __forceinline__ void p1_cumsum(Frame& F) {
    if (blockIdx.x < NB * NH) {
        LAS float* part = (LAS float*)F.lds; const int bh = blockIdx.x, b = bh >> 3, h = bh & 7, tid = TID();
        float v0, v1, v2, v3; { const float* fp = F.FLOG + ((size_t)b * SEQ + tid * 4) * 8 + h; v0 = log_sigmoid(fp[0]); v1 = v0 + log_sigmoid(fp[8]); v2 = v1 + log_sigmoid(fp[16]); v3 = v2 + log_sigmoid(fp[24]); }
        part[tid] = v3; __syncthreads();
        for (int off = 1; off < 512; off <<= 1) { const float tt = tid >= off ? part[tid - off] : 0.f; __syncthreads(); part[tid] += tt; __syncthreads(); }
        const float base = tid ? part[tid - 1] : 0.f;
        *(f32x4*)(F.CN + (size_t)bh * SEQ + tid * 4) = (f32x4){(base + v0) * LOG2E, (base + v1) * LOG2E, (base + v2) * LOG2E, (base + v3) * LOG2E};
    }
    __syncthreads();
}
__device__ __forceinline__ void sgu_unit(Frame& F, int b, int n) {
    typedef float f32x2v __attribute__((ext_vector_type(2)));
    LAS f32x2v* ST = (LAS f32x2v*)(F.lds + SGU_ST_OFF);
    const size_t row0 = (size_t)b * SEQ + (size_t)n * CHUNK; const int lane = LANE_ID();
    for (int r = F.wave * 16; r < F.wave * 16 + 16; ++r) {
        const bf16x8 raw = *(const bf16x8*)(F.GV + (row0 + r) * GW + lane * 8); float x[8]; float s = 0.f;
#pragma unroll
        for (int i = 0; i < 8; ++i) { x[i] = bf2f((bf16)raw[i]); s += x[i]; }
        const float mean = wave_sum(s) * (1.f / GW); float s2 = 0.f;
#pragma unroll
        for (int i = 0; i < 8; ++i) { const float d = x[i] - mean; s2 += d * d; }
        const float rstd = 1.f / sqrtf(wave_sum(s2) * (1.f / GW) + LN_EPS);
        if (lane == 0) ST[r] = (f32x2v){mean, rstd};
    }
    __syncthreads();
    const int g = F.wave, r = lane & 31, h = lane >> 5;
    LAS unsigned char* VT = F.lds + g * 16384;
    {
        const int c8 = (lane & 7) * 8, rs = lane >> 3; const int col = g * 64 + c8;
        const f32x4 ga0 = *(const f32x4*)(F.gln_g + col), ga1 = *(const f32x4*)(F.gln_g + col + 4), be0 = *(const f32x4*)(F.gln_b + col), be1 = *(const f32x4*)(F.gln_b + col + 4);
#pragma unroll 4
        for (int it = 0; it < 16; ++it) { const int sr = it * 8 + rs; const f32x2v st = ST[sr];
            f32x4 x0, x1; pg8::unpack8(*(const u32x4*)(F.GV + (row0 + sr) * GW + col), x0, x1);
            x0 = (x0 - st.x) * st.y * ga0 + be0; x1 = (x1 - st.x) * st.y * ga1 + be1;
            *(LAS u32x4*)(VT + sr * 128 + c8 * 2) = pg8::pack8(x0, x1); }
    }
    LDS_WAIT(); asm volatile("" ::: "memory");
    f32x16 acc[4][2];
#pragma unroll
    for (int ti = 0; ti < 4; ++ti) { acc[ti][0] = f32x16{}; acc[ti][1] = f32x16{}; }
    const bf16* Wg = F.WSP + (size_t)g * CHUNK * CHUNK;
#pragma unroll
    for (int ks = 0; ks < 8; ++ks) {
        bf16x8 b0, b1;
        const LAS bf16* vp = (const LAS bf16*)(VT + (16 * ks + 8 * h) * 128) + r;
#pragma unroll
        for (int j = 0; j < 8; ++j) { b0[j] = (short)vp[j * 64]; b1[j] = (short)vp[j * 64 + 32]; }
#pragma unroll
        for (int ti = 0; ti < 4; ++ti) if (ti >= (ks >> 1)) {
            const bf16x8 a = *(const bf16x8*)(Wg + (size_t)(ti * 32 + r) * CHUNK + 16 * ks + 8 * h);
            acc[ti][0] = __builtin_amdgcn_mfma_f32_32x32x16_bf16(a, b0, acc[ti][0], 0, 0, 0);
            acc[ti][1] = __builtin_amdgcn_mfma_f32_32x32x16_bf16(a, b1, acc[ti][1], 0, 0, 0); }
    }
    LDS_WAIT(); asm volatile("" ::: "memory");
#pragma unroll
    for (int ti = 0; ti < 4; ++ti)
#pragma unroll
        for (int q = 0; q < 16; ++q) { const int t = ti * 32 + (q & 3) + 8 * (q >> 2) + 4 * h; const float bs = F.b_sp[g * CHUNK + t];
            LAS bf16* op = (LAS bf16*)(VT + t * 128) + r; op[0] = f2bf(acc[ti][0][q] + bs); op[32] = f2bf(acc[ti][1][q] + bs); }
    LDS_WAIT(); asm volatile("" ::: "memory");
    {   const int c8 = (lane & 7) * 8, rs = lane >> 3; const int col = g * 64 + c8;
#pragma unroll 4
        for (int it = 0; it < 16; ++it) { const int sr = it * 8 + rs; const size_t idx = (row0 + sr) * GW + col;
            f32x4 s0, s1, u0, u1; pg8::unpack8(*(const LAS u32x4*)(VT + sr * 128 + c8 * 2), s0, s1); pg8::unpack8(*(const u32x4*)(F.GU + idx), u0, u1);
            *(u32x4*)(F.SGU + idx) = pg8::pack8(s0 * u0, s1 * u1); }
    }
    __syncthreads();
}
template <int MODE> __device__ __forceinline__ void ln_row(float* X, size_t row, const float* g, const float* bta, bf16* HBo, bf16* HLo, const bf16* Y, const int* POSREL, const float* TOPG, const LAS int* tb, int lane) {
    float* xr = X + row * DM; f32x4 v[4];
#pragma unroll
    for (int j = 0; j < 4; ++j) v[j] = *(const f32x4*)(xr + 4 * lane + 256 * j);
    if (MODE == 1) {
        const int q0 = POSREL[row * TOPK], q1 = POSREL[row * TOPK + 1], q2 = POSREL[row * TOPK + 2], q3 = POSREL[row * TOPK + 3];
        const f32x4 gt = *(const f32x4*)(TOPG + row * TOPK);
        const int pp[4] = {tb[q0 & 31] * 256 + (q0 >> 5), tb[q1 & 31] * 256 + (q1 >> 5), tb[q2 & 31] * 256 + (q2 >> 5), tb[q3 & 31] * 256 + (q3 >> 5)};
#pragma unroll
        for (int j = 0; j < 4; ++j) { v[j] = v[j] * ALPHA;
#pragma unroll
            for (int k = 0; k < TOPK; ++k) { const u32x2 w = *(const u32x2*)(Y + (size_t)pp[k] * DM + 4 * lane + 256 * j); const float gk = gt[k];
                v[j][0] += gk * __builtin_bit_cast(float, w.x << 16); v[j][1] += gk * __builtin_bit_cast(float, w.x & 0xffff0000u); v[j][2] += gk * __builtin_bit_cast(float, w.y << 16); v[j][3] += gk * __builtin_bit_cast(float, w.y & 0xffff0000u); } }
    }
    float s = 0.f;
#pragma unroll
    for (int j = 0; j < 4; ++j) s += (v[j][0] + v[j][1]) + (v[j][2] + v[j][3]);
    const float mean = wave_sum(s) * (1.f / DM); float s2 = 0.f;
#pragma unroll
    for (int j = 0; j < 4; ++j) { v[j] = v[j] - mean; s2 += (v[j][0] * v[j][0] + v[j][1] * v[j][1]) + (v[j][2] * v[j][2] + v[j][3] * v[j][3]); }
    const float rstd = 1.f / sqrtf(wave_sum(s2) * (1.f / DM) + LN_EPS);
#pragma unroll
    for (int j = 0; j < 4; ++j) { const int c = 4 * lane + 256 * j; const f32x4 gg = *(const f32x4*)(g + c), bb = *(const f32x4*)(bta + c);
        const f32x4 o = v[j] * rstd * gg + bb; *(f32x4*)(xr + c) = o;
        if (HBo) { u32x2 w; w.x = pk2(o[0], o[1]); w.y = pk2(o[2], o[3]); *(u32x2*)(HBo + row * DM + c) = w;
            if (HLo) { u32x2 l; l.x = pk2(o[0] - __builtin_bit_cast(float, w.x << 16), o[1] - __builtin_bit_cast(float, w.x & 0xffff0000u)); l.y = pk2(o[2] - __builtin_bit_cast(float, w.y << 16), o[3] - __builtin_bit_cast(float, w.y & 0xffff0000u)); *(u32x2*)(HLo + row * DM + c) = l; } } }
}
__device__ __forceinline__ void p5_ln1_router(Frame& F) {
    LAS unsigned* LCNT = (LAS unsigned*)F.lds; LAS unsigned* LBASE = LCNT + 32;
    const int lane = LANE_ID(); const size_t row0 = ((size_t)blockIdx.x * 8 + F.wave) * 16;
    if (TID() < 32) LCNT[TID()] = 0u;
    for (int rr = 0; rr < 16; ++rr) ln_row<0>(F.out, row0 + rr, F.ln1g, F.ln1b, F.HB, F.HL, nullptr, nullptr, nullptr, nullptr, lane);
    asm volatile("s_waitcnt vmcnt(0)" ::: "memory");
    __syncthreads();
    f32x4 acc0 = {0.f, 0.f, 0.f, 0.f}, acc1 = {0.f, 0.f, 0.f, 0.f};
    const int ar = lane & 15, kq = lane >> 4;
    const bf16* ah = F.HB + (row0 + ar) * DM + 8 * kq; const bf16* al = F.HL + (row0 + ar) * DM + 8 * kq;
    const bf16* bh0 = F.WRH + (size_t)ar * DM + 8 * kq; const bf16* bh1 = bh0 + 16 * DM; const bf16* bl0 = F.WRL + (size_t)ar * DM + 8 * kq; const bf16* bl1 = bl0 + 16 * DM;
#pragma unroll 4
    for (int ks = 0; ks < 32; ++ks) {
        const bf16x8 xh = *(const bf16x8*)(ah + 32 * ks), xl = *(const bf16x8*)(al + 32 * ks);
        const bf16x8 wh0 = *(const bf16x8*)(bh0 + 32 * ks), wh1 = *(const bf16x8*)(bh1 + 32 * ks), wl0 = *(const bf16x8*)(bl0 + 32 * ks), wl1 = *(const bf16x8*)(bl1 + 32 * ks);
        acc0 = __builtin_amdgcn_mfma_f32_16x16x32_bf16(xh, wh0, acc0, 0, 0, 0); acc1 = __builtin_amdgcn_mfma_f32_16x16x32_bf16(xh, wh1, acc1, 0, 0, 0);
        acc0 = __builtin_amdgcn_mfma_f32_16x16x32_bf16(xh, wl0, acc0, 0, 0, 0); acc1 = __builtin_amdgcn_mfma_f32_16x16x32_bf16(xh, wl1, acc1, 0, 0, 0);
        acc0 = __builtin_amdgcn_mfma_f32_16x16x32_bf16(xl, wh0, acc0, 0, 0, 0); acc1 = __builtin_amdgcn_mfma_f32_16x16x32_bf16(xl, wh1, acc1, 0, 0, 0);
    }
    const float br0 = F.b_r[ar], br1 = F.b_r[16 + ar];
    int e_sel[4]; float g_sel[4];
#pragma unroll
    for (int q = 0; q < 4; ++q) {
        float f0 = __builtin_bit_cast(float, (__builtin_bit_cast(unsigned, acc0[q] + br0) & ~31u) | (unsigned)(31 - ar));
        float f1 = __builtin_bit_cast(float, (__builtin_bit_cast(unsigned, acc1[q] + br1) & ~31u) | (unsigned)(15 - ar));
        float w[4];
#pragma unroll
        for (int it = 0; it < 4; ++it) { float m = fmaxf(f0, f1);
            m = fmaxf(m, __shfl_xor(m, 1)); m = fmaxf(m, __shfl_xor(m, 2)); m = fmaxf(m, __shfl_xor(m, 4)); m = fmaxf(m, __shfl_xor(m, 8));
            w[it] = m; if (f0 == m) f0 = -INFINITY; if (f1 == m) f1 = -INFINITY; }
        const float e1 = __expf(w[1] - w[0]), e2 = __expf(w[2] - w[0]), e3 = __expf(w[3] - w[0]), inv = 1.f / (1.f + e1 + e2 + e3);
        const float wk = ar == 0 ? w[0] : ar == 1 ? w[1] : ar == 2 ? w[2] : w[3];
        e_sel[q] = 31 - (int)(__builtin_bit_cast(unsigned, wk) & 31u);
        g_sel[q] = (ar == 0 ? 1.f : ar == 1 ? e1 : ar == 2 ? e2 : e3) * inv;
    }
    unsigned lpos[4];
    if (ar < 4) {
#pragma unroll
        for (int q = 0; q < 4; ++q) lpos[q] = __hip_atomic_fetch_add(LCNT + e_sel[q], 1u, __ATOMIC_RELAXED, __HIP_MEMORY_SCOPE_WORKGROUP);
    }
    __syncthreads();
    if (TID() < 32) LBASE[TID()] = atomicAdd(F.ctl + CW_CNT + TID(), LCNT[TID()]);
    __syncthreads();
    if (ar < 4) {
#pragma unroll
        for (int q = 0; q < 4; ++q) { const int tk = (int)(row0 + 4 * kq + q) * TOPK + ar; const int pos = (int)(LBASE[e_sel[q]] + lpos[q]); F.LIST[(size_t)e_sel[q] * T + pos] = tk; F.TOPG[tk] = g_sel[q]; F.POS[tk] = (pos << 5) | e_sel[q]; }
    }
}
constexpr int MOE_TB_OFF = LDSCTL_OFF + 1024;
__device__ __forceinline__ void moe_tables(Frame& F) {
    LAS int* CNTL = (LAS int*)(F.lds + MOE_TB_OFF); LAS int* TB = CNTL + 32;
    __syncthreads();
    if (TID() < 32) CNTL[TID()] = (int)__hip_atomic_load(F.ctl + CW_CNT + TID(), RLX_AGENT);
    __syncthreads();
    if (TID() == 0) { int b = 0; for (int e = 0; e < NE; ++e) { TB[e] = b; b += (CNTL[e] + 255) >> 8; } TB[32] = b; }
    __syncthreads();
}
__global__ void __launch_bounds__(NWAVES * 64, 2) mega(MArgs args) {
    extern __shared__ __attribute__((aligned(16))) unsigned char lds_raw[];
    Frame F;
    F.lds = (LAS unsigned char*)lds_raw;
    F.wave = __builtin_amdgcn_readfirstlane((int)threadIdx.x >> 6);
    F.G = gridDim.x; { const int bx = blockIdx.x; F.vcu = (F.G % 8 == 0) ? (bx % 8) * (F.G / 8) + bx / 8 : bx; }
    F.x = args.in[0]; F.p = args.in[1]; F.w_in = args.in[2]; F.b_in = args.in[3]; F.gln_g = args.in[4]; F.gln_b = args.in[5]; F.w_sp = args.in[6]; F.b_sp = args.in[7];
    F.w_a = args.in[8]; F.w_b = args.in[9]; F.w_o = args.in[10]; F.b_o = args.in[11]; F.ln1g = args.in[12]; F.ln1b = args.in[13]; F.w_r = args.in[14]; F.b_r = args.in[15];
    F.w_gu = args.in[16]; F.b_gu = args.in[17]; F.w_dn = args.in[18]; F.b_dn = args.in[19]; F.ln2g = args.in[20]; F.ln2b = args.in[21]; F.w_ple = args.in[22]; F.w_pg = args.in[23];
    F.b_pg = args.in[24]; F.ln3g = args.in[25]; F.ln3b = args.in[26]; F.out = args.out;
    unsigned char* ws = args.ws; F.ctl = (unsigned*)(ws + WS_CTL);
    F.WIN = (bf16*)(ws + WS_WIN); F.WA = (bf16*)(ws + WS_WA); F.WB = (bf16*)(ws + WS_WB); F.WO = (bf16*)(ws + WS_WO); F.WPG = (bf16*)(ws + WS_WPG); F.WPLE = (bf16*)(ws + WS_WPLE);
    F.WSP = (bf16*)(ws + WS_WSP); F.WRH = (bf16*)(ws + WS_WRH); F.WRL = (bf16*)(ws + WS_WRL); F.WGU = (bf16*)(ws + WS_WGU); F.WDN = (bf16*)(ws + WS_WDN); F.HB = (bf16*)(ws + WS_HB); F.PB = (bf16*)(ws + WS_PB);
    F.FLOG = (float*)(ws + WS_FLOG); F.CN = (float*)(ws + WS_CN); F.TOPG = (float*)(ws + WS_TOPG); F.ROWG = (float*)(ws + WS_ROWG);
    F.POS = (int*)(ws + WS_POS); F.LIST = (int*)(ws + WS_LIST); F.ROWTOK = (int*)(ws + WS_ROWTOK); F.TILEE = (int*)(ws + WS_TILEE);
    unsigned char* A = ws + WS_A;
    F.XB = (bf16*)(A + A_XB); F.Q = (bf16*)(A + A_Q); F.K = (bf16*)(A + A_K); F.V = (bf16*)(A + A_V); F.GU = (bf16*)(A + A_GU); F.GV = (bf16*)(A + A_GV); F.GA = (bf16*)(A + A_GA); F.GB = (bf16*)(A + A_GB);
    F.ATT = (bf16*)(A + A_ATT); F.SGU = (bf16*)(A + A_SGU); F.MRG = (bf16*)(A + A_MRG); F.HID = (bf16*)(A + A_HID); F.Y = (bf16*)(A + A_Y); F.HL = (bf16*)(A + A_HL); F.TMPF = (float*)(A + A_TMPF);
    bf16* Gbuf = (bf16*)(A + A_G);
    for (int u = TID(); u < (LDS_BYTES - LDSCTL_OFF) / 4; u += NWAVES * 64) ((LAS unsigned*)(F.lds + LDSCTL_OFF))[u] = 0u;
    __syncthreads();
    volatile LAS unsigned* MISC = (volatile LAS unsigned*)(F.lds + MISC_OFF);
    const int lo = args.ph_lo, hi = args.ph_hi;
    XcdBarrier bar; bar.bar = F.ctl + CW_BAR + args.li * XCD_BAR_WORDS; bar.x = 0; bar.st = nullptr;
    if (hi - lo > 1) bar = xcd_barrier_post(F.ctl + CW_BAR + args.li * XCD_BAR_WORDS, MISC + 8);
#define IN(k) (lo <= (k) && (k) < hi)
#if defined(PROBE_A)
    if (blockIdx.x == 0 && TID() == 0) MISC[16] = (unsigned)__builtin_amdgcn_s_memrealtime();
#define STAMP(id) do { if (((id) == PROBE_A || (id) == PROBE_B) && blockIdx.x == 0 && TID() == 0) { MISC[(id) == PROBE_A ? 17 : 18] = (unsigned)__builtin_amdgcn_s_memrealtime() - MISC[16]; } } while (0)
#define SEAM(k) do { if (IN(k) && IN((k) + 1)) xcd_barrier(bar); STAMP(k); } while (0)
#else
#define STAMP(id) do { } while (0)
#define SEAM(k) do { if (IN(k) && IN((k) + 1)) xcd_barrier(bar); } while (0)
#endif
    const int gw = F.vcu * NWAVES + F.wave, NGW = F.G * NWAVES;

    if (IN(0)) { p0_prologue(F); } SEAM(0);
    if (IN(1)) {
        p1_cumsum(F);
        pg8::DenseOrder S; S.init(F.XB, F.WIN, T, DINC, DM, F.G, (int)blockIdx.x);
        pg8::EpInproj E{F.b_in, F.Q, F.K, F.V, F.GU, F.GV, F.GA, F.GB};
        pg8::gemm_phase<pg8::EpInproj, pg8::DenseOrder, true>(F.lds, DM, S, E);
    } SEAM(1);
    if (IN(2)) {
        sgu_unit(F, F.vcu >> 4, F.vcu & 15); STAMP(100);
        const attn_body::AttnTensors AT{(const attn_body::bf16*)F.Q, (const attn_body::bf16*)F.K, (const attn_body::bf16*)F.V, (attn_body::bf16*)F.ATT, F.CN};
        const attn_body::StaticOrder S((int)F.G, (int)blockIdx.x);
        attn_body::attn_phase<attn_body::StaticOrder>((char*)lds_raw, AT, S);
    } SEAM(2);
    if (IN(3)) {
        { pg8::DenseOrder S; S.init(F.ATT, F.WA, T, DM, FW, F.G, (int)blockIdx.x); pg8::EpBrA E{F.GA, F.TMPF}; pg8::gemm_phase<pg8::EpBrA, pg8::DenseOrder, true>(F.lds, FW, S, E); }
        { pg8::DenseOrder S; S.init(F.SGU, F.WB, T, DM, GW, F.G, (int)blockIdx.x); pg8::EpBrB E{F.GB, F.TMPF, F.MRG}; pg8::gemm_phase<pg8::EpBrB, pg8::DenseOrder, true>(F.lds, GW, S, E); }
    } SEAM(3);
    if (IN(4)) {
        pg8::DenseOrder S; S.init(F.MRG, F.WO, T, DM, DM, F.G, (int)blockIdx.x); pg8::EpOut E{F.x, F.b_o, F.out}; pg8::gemm_phase<pg8::EpOut, pg8::DenseOrder, true>(F.lds, DM, S, E);
    } SEAM(4);
    if (IN(5)) { p5_ln1_router(F); } SEAM(5);
    if (IN(6)) {
        moe_tables(F);
        const LAS int* CNTL = (const LAS int*)(F.lds + MOE_TB_OFF);
        pg8::MoeOrder S{CNTL + 32, CNTL, F.LIST, (const char*)F.HB, (const char*)F.WGU, (size_t)2 * DFF * DM * 2, DM, 8, (int)blockIdx.x, true}; pg8::EpGU E{F.b_gu, F.HID};
        pg8::gemm_phase<pg8::EpGU, pg8::MoeOrder, true>(F.lds, DM, S, E);
    } SEAM(6);
    if (IN(7)) {
        moe_tables(F);
        const LAS int* CNTL = (const LAS int*)(F.lds + MOE_TB_OFF);
        pg8::MoeOrder S{CNTL + 32, CNTL, F.LIST, (const char*)F.HID, (const char*)F.WDN, (size_t)DM * DFF * 2, DFF, 4, (int)blockIdx.x, false}; pg8::EpDn E{F.b_dn, F.Y};
        pg8::gemm_phase<pg8::EpDn, pg8::MoeOrder, true>(F.lds, DFF, S, E);
    } SEAM(7);
    if (IN(8)) {
        moe_tables(F);
        const LAS int* TB = (const LAS int*)(F.lds + MOE_TB_OFF) + 32;
        for (int row = gw; row < T; row += NGW) ln_row<1>(F.out, (size_t)row, F.ln2g, F.ln2b, F.HB, nullptr, F.Y, F.POS, F.TOPG, TB, LANE_ID());
    } SEAM(8);
    if (IN(9)) {
        pg8::DenseOrder S; S.init(F.HB, F.WPG, T, DM, DM, F.G, (int)blockIdx.x); pg8::EpPG E{F.b_pg, Gbuf}; pg8::gemm_phase<pg8::EpPG, pg8::DenseOrder, true>(F.lds, DM, S, E);
    } SEAM(9);
    if (IN(10)) {
        pg8::DenseOrder S; S.init(F.PB, F.WPLE, T, DM, PLE, F.G, (int)blockIdx.x); pg8::EpPle E{Gbuf, F.out}; pg8::gemm_phase<pg8::EpPle, pg8::DenseOrder, true>(F.lds, PLE, S, E);
    } SEAM(10);
    if (IN(11)) { for (int row = gw; row < T; row += NGW) ln_row<0>(F.out, (size_t)row, F.ln3g, F.ln3b, nullptr, nullptr, nullptr, nullptr, nullptr, nullptr, LANE_ID()); }
#if defined(PROBE_A)
    STAMP(11);
    for (int row = gw; row < 4096; row += NGW) { float* xr = F.out + (size_t)row * DM;
#pragma unroll
        for (int j = 0; j < 4; ++j) { f32x4 v = *(f32x4*)(xr + 4 * LANE_ID() + 256 * j); v = v + 0.25f; *(f32x4*)(xr + 4 * LANE_ID() + 256 * j) = v; } }
    if (blockIdx.x == 0 && TID() == 0) F.out[0] = (float)(MISC[17] - MISC[18]) * 0.0001f;
#endif
#undef IN
#undef SEAM
}

extern "C" void kernel_launch(void* const* d_in, const int* in_sizes, int n_in, void* d_out, int out_size, void* d_ws, size_t ws_size, hipStream_t stream) {
    if (n_in != 27 || out_size != T * DM || ws_size < WS_END) { fprintf(stderr, "kernel_launch: unexpected shapes (n_in %d out %d ws %zu)\n", n_in, out_size, ws_size); return; }
    static int grid = 0;
    if (grid == 0) {
        int dev = 0, cus = 0, per_cu = 0;
        if (hipGetDevice(&dev) != hipSuccess || hipDeviceGetAttribute(&cus, hipDeviceAttributeMultiprocessorCount, dev) != hipSuccess) { fprintf(stderr, "kernel_launch: device query failed\n"); grid = -1; return; }
        if (hipFuncSetAttribute((const void*)mega, hipFuncAttributeMaxDynamicSharedMemorySize, LDS_BYTES) != hipSuccess) { fprintf(stderr, "kernel_launch: hipFuncSetAttribute failed\n"); grid = -1; return; }
        if (hipOccupancyMaxActiveBlocksPerMultiprocessor(&per_cu, (const void*)mega, NWAVES * 64, LDS_BYTES) != hipSuccess || per_cu < 1) { fprintf(stderr, "kernel_launch: occupancy query says %d workgroups per CU\n", per_cu); per_cu = 1; }
        (void)hipGetLastError();
        grid = cus;
        if (grid != 256) fprintf(stderr, "kernel_launch: %d CUs (built for 256)\n", grid);
    }
    if (grid < 0) return;
    unsigned char* ws = (unsigned char*)d_ws; float* out = (float*)d_out;
    (void)hipMemsetAsync(ws + WS_CTL, 0, CTL_BYTES, stream);
    MArgs ma; for (int i = 0; i < 27; ++i) ma.in[i] = (const float*)d_in[i]; ma.out = out; ma.ws = ws; ma.ph_lo = 0; ma.ph_hi = 0; ma.li = 0; ma.pad = 0;
    ma.ph_lo = 0; ma.ph_hi = NPHASE; ma.li = 0;
    hipLaunchKernelGGL(mega, dim3(grid), dim3(NWAVES * 64), LDS_BYTES, stream, ma);
}
```
